# Optimizing an MI355X kernel written in HIP

```python
import jax, jax.numpy as jnp
from jax import lax
import numpy as np

D_MODEL = 2048
BATCH = 4
SEQ = 4096
DEPTH = 1
DEC_BATCH = 4
DEC_SEQ = 8192
PAST_LEN = 128

GRID_W = 64
HEAD_DIM = 128
N_Q_HEADS = 8
N_KV_HEADS = 2
Q_PER_KV = N_Q_HEADS // N_KV_HEADS
ATTN_WIDTH = N_Q_HEADS * HEAD_DIM
KV_WIDTH = N_KV_HEADS * HEAD_DIM
POOL_WINDOWS = (2, 4, 8, 16)
N_POOL_GROUPS = len(POOL_WINDOWS)
POOL_GROUP_WIDTH = 256
POOL_WIDTH = N_POOL_GROUPS * POOL_GROUP_WIDTH
MIX_WIDTH = ATTN_WIDTH + POOL_WIDTH
IN_WIDTH = ATTN_WIDTH + 2 * KV_WIDTH + POOL_WIDTH
D_FF = 5632
CONV_WIDTH = 3
ROPE_THETA = 10000.0
ROPE_AXIS_DIM = HEAD_DIM // 2
Q_BLOCK = 128
EPS = 1e-6

kernel_name = "hymba_style_gqa_pool_convglu_encoder"


def rmsnorm(x, g):
    xf = x.astype(jnp.float32)
    y = xf * lax.rsqrt(jnp.mean(xf * xf, axis=-1, keepdims=True) + EPS)
    return (y * g.astype(jnp.float32)).astype(x.dtype)


def axial_rope_tables(L):
    rows = L // GRID_W
    row = jnp.repeat(jnp.arange(rows, dtype=jnp.float32), GRID_W)
    col = jnp.tile(jnp.arange(GRID_W, dtype=jnp.float32), rows)
    inv_freq = ROPE_THETA ** (-jnp.arange(0, ROPE_AXIS_DIM, 2, dtype=jnp.float32) / ROPE_AXIS_DIM)
    ang = jnp.stack([row[:, None] * inv_freq, col[:, None] * inv_freq], axis=1)
    return jnp.cos(ang), jnp.sin(ang)


def apply_axial_rope(x, cos, sin):
    B, L, H, _ = x.shape
    xf = x.astype(jnp.float32).reshape(B, L, H, 2, ROPE_AXIS_DIM)
    x1, x2 = xf[..., : ROPE_AXIS_DIM // 2], xf[..., ROPE_AXIS_DIM // 2:]
    c, s = cos[None, :, None], sin[None, :, None]
    out = jnp.concatenate([x1 * c - x2 * s, x2 * c + x1 * s], axis=-1)
    return out.reshape(B, L, H, HEAD_DIM).astype(x.dtype)


def bidir_gqa(q, k, v):
    B, L, _, _ = q.shape
    nblk = L // Q_BLOCK
    qb = q.reshape(B, nblk, Q_BLOCK, N_KV_HEADS, Q_PER_KV, HEAD_DIM).transpose(1, 0, 2, 3, 4, 5)
    scale = HEAD_DIM ** -0.5

    def one_block(q_blk):
        s = jnp.einsum('bqkgd,bskd->bkgqs', q_blk, k, preferred_element_type=jnp.float32) * scale
        p = jax.nn.softmax(s, axis=-1)
        return jnp.einsum('bkgqs,bskd->bqkgd', p.astype(v.dtype), v)

    ob = lax.map(one_block, qb)
    return ob.transpose(1, 0, 2, 3, 4, 5).reshape(B, L, ATTN_WIDTH)


def multiscale_pool(u, w_pool, pool_scale):
    B, L, _ = u.shape
    uf = u.astype(jnp.float32).reshape(B, L, N_POOL_GROUPS, POOL_GROUP_WIDTH)
    csum = jnp.concatenate([jnp.zeros((B, 1, N_POOL_GROUPS, POOL_GROUP_WIDTH), jnp.float32),
                            jnp.cumsum(uf, axis=1)], axis=1)
    t = jnp.arange(L)
    outs = []
    for g, w in enumerate(POOL_WINDOWS):
        lo = jnp.clip(t - w // 2, 0, L)
        hi = jnp.clip(t + w // 2, 0, L)
        cnt = (hi - lo).astype(jnp.float32)
        cs = csum[:, :, g]
        mean = (cs[:, hi] - cs[:, lo]) / cnt[None, :, None]
        outs.append(mean - uf[:, :, g])
    d = jnp.stack(outs, axis=2).astype(u.dtype)
    y = jnp.einsum('blgc,gcd->blgd', d, w_pool)
    return y.reshape(B, L, POOL_WIDTH) * pool_scale


def dwconv_centred(h, w, b):
    hp = jnp.pad(h, ((0, 0), (1, 1), (0, 0)))
    return hp[:, :-2] * w[0] + hp[:, 1:-1] * w[1] + hp[:, 2:] * w[2] + b


def encoder_layer(x, g_norm_mix, w_in, g_q, g_k, w_pool, pool_scale, w_out,
                  g_norm_ffn, w_up, w_conv, b_conv, w_down):
    B, L, _ = x.shape
    h = rmsnorm(x, g_norm_mix)
    z = h @ w_in
    q = z[..., :ATTN_WIDTH].reshape(B, L, N_Q_HEADS, HEAD_DIM)
    k = z[..., ATTN_WIDTH:ATTN_WIDTH + KV_WIDTH].reshape(B, L, N_KV_HEADS, HEAD_DIM)
    v = z[..., ATTN_WIDTH + KV_WIDTH:ATTN_WIDTH + 2 * KV_WIDTH].reshape(B, L, N_KV_HEADS, HEAD_DIM)
    u = z[..., ATTN_WIDTH + 2 * KV_WIDTH:]
    cos, sin = axial_rope_tables(L)
    q = apply_axial_rope(rmsnorm(q, g_q), cos, sin)
    k = apply_axial_rope(rmsnorm(k, g_k), cos, sin)
    a = bidir_gqa(q, k, v)
    m = multiscale_pool(u, w_pool, pool_scale)
    x = x + jnp.concatenate([a, m], axis=-1) @ w_out
    h = rmsnorm(x, g_norm_ffn)
    gu = h @ w_up
    gate = dwconv_centred(gu[..., :D_FF], w_conv, b_conv)
    val = gu[..., D_FF:]
    return x + (jax.nn.silu(gate) * val) @ w_down


def run_trunk(x, g_norm_mix, w_in, g_q, g_k, w_pool, pool_scale, w_out,
              g_norm_ffn, w_up, w_conv, b_conv, w_down):
    for i in range(DEPTH):
        x = encoder_layer(x, g_norm_mix[i], w_in[i], g_q[i], g_k[i], w_pool[i], pool_scale[i],
                          w_out[i], g_norm_ffn[i], w_up[i], w_conv[i], b_conv[i], w_down[i])
    return x


def setup_inputs(seed: int = 0) -> dict:
    key = jax.random.key(seed)
    ks = jax.random.split(key, 16)
    f32 = jnp.float32
    nrm = lambda k, shape, s: jax.random.normal(k, shape, f32) * s
    return {
        "x_prompt": nrm(ks[0], (BATCH, SEQ, D_MODEL), 1.0),
        "x_sample": nrm(ks[1], (DEC_BATCH, DEC_SEQ, D_MODEL), 1.0),
        "g_norm_mix": 1.0 + nrm(ks[2], (DEPTH, D_MODEL), 0.02),
        "w_in": nrm(ks[3], (DEPTH, D_MODEL, IN_WIDTH), D_MODEL ** -0.5),
        "g_q": 1.0 + nrm(ks[4], (DEPTH, HEAD_DIM), 0.02),
        "g_k": 1.0 + nrm(ks[5], (DEPTH, HEAD_DIM), 0.02),
        "w_pool": nrm(ks[6], (DEPTH, N_POOL_GROUPS, POOL_GROUP_WIDTH, POOL_GROUP_WIDTH), POOL_GROUP_WIDTH ** -0.5),
        "pool_scale": 1.0 + nrm(ks[7], (DEPTH, POOL_WIDTH), 0.02),
        "w_out": nrm(ks[8], (DEPTH, MIX_WIDTH, D_MODEL), MIX_WIDTH ** -0.5),
        "g_norm_ffn": 1.0 + nrm(ks[9], (DEPTH, D_MODEL), 0.02),
        "w_up": nrm(ks[10], (DEPTH, D_MODEL, 2 * D_FF), D_MODEL ** -0.5),
        "w_conv": nrm(ks[11], (DEPTH, CONV_WIDTH, D_FF), CONV_WIDTH ** -0.5),
        "b_conv": nrm(ks[12], (DEPTH, D_FF), 0.01),
        "w_down": nrm(ks[13], (DEPTH, D_FF, D_MODEL), D_FF ** -0.5),
    }


def reference(x_prompt, x_sample, g_norm_mix, w_in, g_q, g_k, w_pool, pool_scale, w_out,
              g_norm_ffn, w_up, w_conv, b_conv, w_down):
    y_prompt = run_trunk(x_prompt, g_norm_mix, w_in, g_q, g_k, w_pool, pool_scale, w_out,
                         g_norm_ffn, w_up, w_conv, b_conv, w_down)
    y_sample = run_trunk(x_sample, g_norm_mix, w_in, g_q, g_k, w_pool, pool_scale, w_out,
                         g_norm_ffn, w_up, w_conv, b_conv, w_down)
    return (y_prompt, y_sample)
```

```cpp
#include <hip/hip_runtime.h>
#include <hip/hip_bf16.h>
#include <hip/hip_cooperative_groups.h>
#include <cstdio>
#include <cstdint>
#include <cmath>
namespace cg = cooperative_groups;

constexpr int DMODEL = 2048, M_P = 16384, M_S = 32768, M_ALL = 49152, L_P = 4096, L_S = 8192;
constexpr int N_IN = 2560, D_FF = 5632, N_UP = 11264, N_TILES_M = M_ALL / 256;
constexpr float RMS_EPS = 1e-6f;
namespace pg8 {
#define PG8_LAS __attribute__((address_space(3)))
typedef unsigned short bf16_t;
typedef short bf16x8 __attribute__((ext_vector_type(8)));
typedef float f32x4 __attribute__((ext_vector_type(4)));
typedef unsigned u32x4 __attribute__((ext_vector_type(4)));
constexpr int BM = 256, BK = 64, HALF = 128, HTB = HALF * BK * 2  , STAGE_BYTES = 8 * HTB, NXCD = 8, WGM = 8;

__host__ __device__ __forceinline__ int lds_byte(int r, int c) { const int st = (r >> 4) * 2 + (c >> 5), rr = r & 15, cc = c & 31, ob = rr * 64 + cc * 2; return st * 1024 + (ob ^ (((ob >> 9) & 1) << 5)); }
__host__ __device__ __forceinline__ void stage_rc(int b, int& R, int& C) { const int st = b / 1024, sb = b % 1024, swz = sb ^ (((sb >> 9) & 1) << 5); R = (st >> 1) * 16 + swz / 64; C = (st & 1) * 32 + (swz % 64) / 2; }
__host__ __device__ __forceinline__ int perm32(int rho) { const int n = rho >> 4, i = rho & 15; return 8 * (i >> 2) + 4 * n + (i & 3); }

struct Unit { int pm, pn; };
struct Gemm { const bf16_t* A; const bf16_t* Bt; int M, N, K; };

struct StaticOrder {
    int nM, nN, nwg, G, c, reps;
    __host__ __device__ void init(int M, int N, int G_, int c_) { nM = M / BM; nN = N / BM; nwg = nM * nN; G = G_; c = c_; reps = 1; }
    __host__ __device__ bool next(int i, Unit& u) const {
        const long L = (long)i * G + c; if (L >= (long)nwg * reps) return false;
        int wgid = (int)(L % nwg); { const int q = nwg / NXCD, r = nwg % NXCD, xcd = wgid % NXCD, off = wgid / NXCD; wgid = (xcd < r ? xcd * (q + 1) : r * (q + 1) + (xcd - r) * q) + off; }
        const int nig = WGM * nN, gid = wgid / nig, fm = gid * WGM, gsz = (nM - fm) < WGM ? (nM - fm) : WGM;
        u.pm = fm + ((wgid % nig) % gsz); u.pn = (wgid % nig) / gsz; return true;
    }
    __device__ __forceinline__ void a_ready(const Unit&) const {}
    __device__ __forceinline__ void done(const Unit&) const {}
};
__device__ __forceinline__ unsigned cvt_pk_bf16(float lo, float hi) { unsigned r; asm volatile("v_cvt_pk_bf16_f32 %0, %1, %2" : "=v"(r) : "v"(lo), "v"(hi)); return r; }
typedef float f32x2 __attribute__((ext_vector_type(2)));
constexpr int D_FF_C = 5632;
struct EpiBf16 {
    static constexpr bool PERM = true, AFTER_DRAIN = false;
    bf16_t* O; int ldc; int pm_mod; int col_off; const float* cscale;
    __device__ __forceinline__ void operator()(const f32x4 (&acc)[2][2][4][2], const Unit& u, int wr, int wc, int fr, int fq) const {
        const int pm = pm_mod ? (u.pm % pm_mod) : u.pm;
        const int row0 = pm * BM + wr * 64 + fr; const int lc = u.pn * BM + wc * 32 + 8 * fq;
        f32x4 sv[2][2];
#pragma unroll
        for (int bj = 0; bj < 2; ++bj)
#pragma unroll
            for (int n = 0; n < 2; ++n) sv[bj][n] = cscale ? *(const f32x4*)(cscale + lc + bj * HALF + 4 * n) : (f32x4){1.f, 1.f, 1.f, 1.f};
#pragma unroll
        for (int ai = 0; ai < 2; ++ai)
#pragma unroll
            for (int m = 0; m < 4; ++m) { bf16_t* rowp = O + (size_t)(row0 + ai * HALF + m * 16) * ldc + col_off + lc;
#pragma unroll
                for (int bj = 0; bj < 2; ++bj) { const f32x4 v0 = acc[ai][bj][m][0] * sv[bj][0], v1 = acc[ai][bj][m][1] * sv[bj][1];
                    u32x4 w; w.x = cvt_pk_bf16(v0[0], v0[1]); w.y = cvt_pk_bf16(v0[2], v0[3]); w.z = cvt_pk_bf16(v1[0], v1[1]); w.w = cvt_pk_bf16(v1[2], v1[3]);
                    *(u32x4*)(rowp + bj * HALF) = w; } }
    }
};
struct EpiResOut {
    static constexpr bool PERM = false, AFTER_DRAIN = false;
    const bf16_t* xb; float* out;
    __device__ __forceinline__ void operator()(const f32x4 (&acc)[2][2][4][2], const Unit& u, int wr, int wc, int fr, int fq) const {
        typedef unsigned u32x2 __attribute__((ext_vector_type(2)));
        const int col0 = u.pn * BM + wc * 32 + 4 * fq;
        u32x2 xv[2][4][2][2];
#pragma unroll
        for (int ai = 0; ai < 2; ++ai)
#pragma unroll
            for (int m = 0; m < 4; ++m) { const size_t r = (size_t)u.pm * BM + ai * HALF + wr * 64 + m * 16 + fr;
#pragma unroll
                for (int bj = 0; bj < 2; ++bj)
#pragma unroll
                    for (int n = 0; n < 2; ++n) xv[ai][m][bj][n] = *(const u32x2*)(xb + r * 2048 + col0 + bj * HALF + n * 16); }
#pragma unroll
        for (int ai = 0; ai < 2; ++ai)
#pragma unroll
            for (int m = 0; m < 4; ++m) { const size_t r = (size_t)u.pm * BM + ai * HALF + wr * 64 + m * 16 + fr; float* orow = out + r * 2048;
#pragma unroll
                for (int bj = 0; bj < 2; ++bj)
#pragma unroll
                    for (int n = 0; n < 2; ++n) { const u32x2 w = xv[ai][m][bj][n];
                        const f32x4 b = (f32x4){__uint_as_float(w.x << 16), __uint_as_float(w.x & 0xffff0000u), __uint_as_float(w.y << 16), __uint_as_float(w.y & 0xffff0000u)};
                        *(f32x4*)(orow + col0 + bj * HALF + n * 16) = b + acc[ai][bj][m][n]; } }
    }
};
struct EpiResNorm {
    static constexpr bool PERM = false, AFTER_DRAIN = false;
    const float* xp; const float* xs; bf16_t* xn; float* ss; PG8_LAS float* P;
    __device__ __forceinline__ void operator()(const f32x4 (&acc)[2][2][4][2], const Unit& u, int wr, int wc, int fr, int fq) const {
        typedef unsigned u32x2 __attribute__((ext_vector_type(2)));
        const int col0 = u.pn * BM + wc * 32 + 4 * fq;
#pragma unroll
        for (int ai = 0; ai < 2; ++ai) {
            f32x4 xv[4][2][2];
#pragma unroll
            for (int m = 0; m < 4; ++m) { const int r = u.pm * BM + ai * HALF + wr * 64 + m * 16 + fr;
                const float* xr = r < 16384 ? xp + (size_t)r * 2048 : xs + (size_t)(r - 16384) * 2048;
#pragma unroll
                for (int bj = 0; bj < 2; ++bj)
#pragma unroll
                    for (int n = 0; n < 2; ++n) xv[m][bj][n] = *(const f32x4*)(xr + col0 + bj * HALF + n * 16); }
            asm volatile("" ::: "memory");
#pragma unroll
            for (int m = 0; m < 4; ++m) { const int rl = ai * HALF + wr * 64 + m * 16 + fr, r = u.pm * BM + rl;
                bf16_t* nrow = xn + (size_t)r * 2048; float sq = 0.f;
#pragma unroll
                for (int bj = 0; bj < 2; ++bj)
#pragma unroll
                    for (int n = 0; n < 2; ++n) { const int c = col0 + bj * HALF + n * 16; const f32x4 v = xv[m][bj][n] + acc[ai][bj][m][n];
                        sq += (v[0] * v[0] + v[1] * v[1]) + (v[2] * v[2] + v[3] * v[3]);
                        u32x2 w; w.x = cvt_pk_bf16(v[0], v[1]); w.y = cvt_pk_bf16(v[2], v[3]); *(u32x2*)(nrow + c) = w; }
                sq += __shfl_xor(sq, 16); sq += __shfl_xor(sq, 32);
                if (fq == 0) P[rl * 4 + wc] = sq; }
            asm volatile("" ::: "memory");
        }
        asm volatile("s_waitcnt lgkmcnt(0)" ::: "memory"); __builtin_amdgcn_s_barrier(); asm volatile("" ::: "memory");
        const int t = (wr * 4 + wc) * 64 + fq * 16 + fr;
        if (t < 256) { const f32x4 p = *(const PG8_LAS f32x4*)(P + t * 4); ss[(size_t)u.pn * 49152 + u.pm * BM + t] = (p[0] + p[1]) + (p[2] + p[3]); }
    }
};
__device__ __forceinline__ float dpp_ror1(float v) { return __builtin_bit_cast(float, __builtin_amdgcn_update_dpp(0, __builtin_bit_cast(int, v), 0x121, 0xf, 0xf, false)); }
__device__ __forceinline__ float dpp_ror15(float v) { return __builtin_bit_cast(float, __builtin_amdgcn_update_dpp(0, __builtin_bit_cast(int, v), 0x12F, 0xf, 0xf, false)); }
__device__ __forceinline__ f32x4 ror1_4(f32x4 v) { return (f32x4){dpp_ror1(v[0]), dpp_ror1(v[1]), dpp_ror1(v[2]), dpp_ror1(v[3])}; }
__device__ __forceinline__ f32x4 ror15_4(f32x4 v) { return (f32x4){dpp_ror15(v[0]), dpp_ror15(v[1]), dpp_ror15(v[2]), dpp_ror15(v[3])}; }
__device__ __forceinline__ float silu_f(float s) { return s * __builtin_amdgcn_rcpf(1.0f + __builtin_amdgcn_exp2f(-1.4426950408889634f * s)); }
struct EpiConvGlu {
    static constexpr bool PERM = true, AFTER_DRAIN = false;
    bf16_t* act; const float* wconv; const float* bconv; float* hS; float* hV; float* hG; PG8_LAS float* xch; const float* rstd;
    __device__ __forceinline__ void operator()(f32x4 (&acc)[2][2][4][2], const Unit& u, int wr, int wc, int fr, int fq) const {
        const int cl = wc * 32 + 8 * fq, gc = u.pn * HALF + cl;
        f32x4 w0[2], w1[2], w2[2], bb[2];
#pragma unroll
        for (int n = 0; n < 2; ++n) { w0[n] = *(const f32x4*)(wconv + gc + 4 * n); w1[n] = *(const f32x4*)(wconv + D_FF_C + gc + 4 * n);
            w2[n] = *(const f32x4*)(wconv + 2 * D_FF_C + gc + 4 * n); bb[n] = *(const f32x4*)(bconv + gc + 4 * n); }
        float rs[2][4];
#pragma unroll
        for (int ai = 0; ai < 2; ++ai)
#pragma unroll
            for (int m = 0; m < 4; ++m) rs[ai][m] = rstd[u.pm * BM + ai * HALF + wr * 64 + m * 16 + fr];
#pragma unroll
        for (int ai = 0; ai < 2; ++ai)
#pragma unroll
            for (int m = 0; m < 4; ++m)
#pragma unroll
                for (int bj = 0; bj < 2; ++bj)
#pragma unroll
                    for (int n = 0; n < 2; ++n) acc[ai][bj][m][n] = acc[ai][bj][m][n] * rs[ai][m];
#pragma unroll
        for (int ai = 0; ai < 2; ++ai) { const int blk = 2 * ai + wr;
            if (fr == 0) { *(PG8_LAS f32x4*)(xch + (blk * 2 + 0) * HALF + cl) = acc[ai][0][0][0]; *(PG8_LAS f32x4*)(xch + (blk * 2 + 0) * HALF + cl + 4) = acc[ai][0][0][1]; }
            if (fr == 15) { *(PG8_LAS f32x4*)(xch + (blk * 2 + 1) * HALF + cl) = acc[ai][0][3][0]; *(PG8_LAS f32x4*)(xch + (blk * 2 + 1) * HALF + cl + 4) = acc[ai][0][3][1]; } }
        asm volatile("s_waitcnt lgkmcnt(0)" ::: "memory"); __builtin_amdgcn_s_barrier(); asm volatile("" ::: "memory");
#pragma unroll
        for (int ai = 0; ai < 2; ++ai) { const int blk = 2 * ai + wr;
            f32x4 top[2], bot[2];
#pragma unroll
            for (int n = 0; n < 2; ++n) {
                top[n] = blk > 0 ? *(const PG8_LAS f32x4*)(xch + ((blk - 1) * 2 + 1) * HALF + cl + 4 * n) : (f32x4){0.f, 0.f, 0.f, 0.f};
                bot[n] = blk < 3 ? *(const PG8_LAS f32x4*)(xch + ((blk + 1) * 2 + 0) * HALF + cl + 4 * n) : (f32x4){0.f, 0.f, 0.f, 0.f}; }
#pragma unroll
            for (int m = 0; m < 4; ++m) { const int rl = ai * HALF + wr * 64 + m * 16 + fr; const size_t r = (size_t)u.pm * BM + rl;
                u32x4 w;
#pragma unroll
                for (int n = 0; n < 2; ++n) {
                    const f32x4 g = acc[ai][0][m][n];
                    f32x4 up = ror1_4(g), dn = ror15_4(g);
                    if (m > 0) { const f32x4 pu = ror1_4(acc[ai][0][m > 0 ? m - 1 : 0][n]); if (fr == 0) up = pu; } else { if (fr == 0) up = top[n]; }
                    if (m < 3) { const f32x4 pd = ror15_4(acc[ai][0][m < 3 ? m + 1 : 3][n]); if (fr == 15) dn = pd; } else { if (fr == 15) dn = bot[n]; }
                    const f32x4 s = w0[n] * up + w1[n] * g + w2[n] * dn + bb[n];
                    const f32x4 v = acc[ai][1][m][n];
                    const f32x4 a = (f32x4){silu_f(s[0]) * v[0], silu_f(s[1]) * v[1], silu_f(s[2]) * v[2], silu_f(s[3]) * v[3]};
                    if (n == 0) { w.x = cvt_pk_bf16(a[0], a[1]); w.y = cvt_pk_bf16(a[2], a[3]); } else { w.z = cvt_pk_bf16(a[0], a[1]); w.w = cvt_pk_bf16(a[2], a[3]); }
                    if (rl == 0 || rl == 255) { const size_t ho = ((size_t)u.pm * 2 + (rl ? 1 : 0)) * D_FF_C + gc + 4 * n;
                        *(f32x4*)(hS + ho) = s; *(f32x4*)(hV + ho) = v; *(f32x4*)(hG + ho) = g; }
                }
                *(u32x4*)(act + r * D_FF_C + gc) = w; } }
    }
};
template <class Epi, class Sched, bool ALIGN_EPI = false, bool SP2 = false>
__device__ __forceinline__ void gemm_phase(PG8_LAS unsigned char* lds, const Gemm g, const Sched& S, const Epi& E, const int mk_wave) {
    const int lane = (int)__builtin_amdgcn_mbcnt_hi(~0u, __builtin_amdgcn_mbcnt_lo(~0u, 0u)), wid = mk_wave, tid = wid * 64 + lane, wr = wid >> 2, wc = wid & 3, fr = lane & 15, fq = lane >> 4;
    const int K = g.K, nt = K / BK;
    unsigned voffA[2], voffB[2];
#pragma unroll
    for (int i = 0; i < 2; ++i) { int R, C; stage_rc(tid * 16 + i * 8192, R, C); const int Rb = Epi::PERM ? ((R & ~31) + perm32(R & 31)) : R;
        voffA[i] = (unsigned)(R * K + C) * 2u; voffB[i] = (unsigned)(Rb * K + C) * 2u; }
    const size_t kstep = (size_t)(BK * 2);
    const size_t hstep = (size_t)HALF * K * 2;
    const size_t tstep = 2 * hstep;
    const unsigned ldsw = (unsigned)wid * 1024u;
    const int aoff = lds_byte(wr * 64 + fr, fq * 8), boff = lds_byte(wc * 32 + fr, fq * 8);
#define PG8_SA(b, h) (((b) * 2 + (h)) * HTB)
#define PG8_SB(b, h) ((4 + (b) * 2 + (h)) * HTB)
#define PG8_STAGE(bufoff, gbase, voff) do { _Pragma("unroll") for (int _i = 0; _i < 2; ++_i) \
        __builtin_amdgcn_global_load_lds((const unsigned*)((const char*)(gbase) + (voff)[_i]), (PG8_LAS unsigned*)(lds + (bufoff) + ldsw + _i * 8192), 16, 0, 0); } while (0)
#define PG8_LDA(dst, b, h) do { _Pragma("unroll") for (int m = 0; m < 4; ++m) _Pragma("unroll") for (int k = 0; k < 2; ++k) dst[m][k] = *(const PG8_LAS bf16x8*)(lds + PG8_SA(b, h) + aoff + m * 2048 + k * 1024); } while (0)
#define PG8_LDB(dst, b, h) do { _Pragma("unroll") for (int n = 0; n < 2; ++n) _Pragma("unroll") for (int k = 0; k < 2; ++k) dst[n][k] = *(const PG8_LAS bf16x8*)(lds + PG8_SB(b, h) + boff + n * 2048 + k * 1024); } while (0)
#define PG8_MMA(ai, bj, At, Bt) do { __builtin_amdgcn_s_setprio(1); _Pragma("unroll") for (int m = 0; m < 4; ++m) _Pragma("unroll") for (int n = 0; n < 2; ++n) _Pragma("unroll") for (int k = 0; k < 2; ++k) \
        acc[ai][bj][m][n] = __builtin_amdgcn_mfma_f32_16x16x32_bf16(Bt[n][k], At[m][k], acc[ai][bj][m][n], 0, 0, 0); __builtin_amdgcn_s_setprio(0); } while (0)
#define PG8_WAIT_V(n) asm volatile("s_waitcnt vmcnt(" #n ")" ::: "memory")
#define PG8_WAIT_L(n) asm volatile("s_waitcnt lgkmcnt(" #n ")" ::: "memory")
#define PG8_BAR __builtin_amdgcn_s_barrier()
#define PG8_SCHED __builtin_amdgcn_sched_barrier(0)
    Unit cur, nxt; int ui = 0;
    if (!S.next(0, cur)) return;
    f32x4 acc[2][2][4][2];
#pragma unroll
    for (int a = 0; a < 2; ++a)
#pragma unroll
        for (int b = 0; b < 2; ++b)
#pragma unroll
            for (int m = 0; m < 4; ++m)
#pragma unroll
                for (int n = 0; n < 2; ++n) acc[a][b][m][n] = (f32x4){0.f, 0.f, 0.f, 0.f};
    bf16x8 At[4][2], B0[2][2], B1[2][2];
    const char* cA = (const char*)g.A + (size_t)cur.pm * tstep; const char* cB = (const char*)g.Bt + (size_t)cur.pn * tstep;
    S.a_ready(cur);
    if constexpr (SP2) {
        PG8_STAGE(PG8_SB(0, 0), cB, voffB); PG8_STAGE(PG8_SB(0, 1), cB + hstep, voffB); PG8_STAGE(PG8_SA(0, 0), cA, voffA); PG8_STAGE(PG8_SA(0, 1), cA + hstep, voffA);
        if (wr == 1) PG8_BAR;
        PG8_WAIT_V(2); PG8_BAR;
        PG8_STAGE(PG8_SB(1, 0), cB + kstep, voffB); PG8_STAGE(PG8_SA(1, 0), cA + kstep, voffA); PG8_STAGE(PG8_SB(1, 1), cB + hstep + kstep, voffB);
        PG8_WAIT_V(6); PG8_BAR;
    } else {
        PG8_STAGE(PG8_SB(0, 0), cB, voffB); PG8_STAGE(PG8_SA(0, 0), cA, voffA); PG8_STAGE(PG8_SB(0, 1), cB + hstep, voffB); PG8_STAGE(PG8_SA(0, 1), cA + hstep, voffA);
        if (wr == 1) PG8_BAR;
        PG8_WAIT_V(4); PG8_BAR;
        PG8_STAGE(PG8_SB(1, 0), cB + kstep, voffB); PG8_STAGE(PG8_SA(1, 0), cA + kstep, voffA); PG8_STAGE(PG8_SB(1, 1), cB + hstep + kstep, voffB);
        PG8_WAIT_V(6); PG8_BAR;
    }
    for (;;) {
        const bool has_next = S.next(ui + 1, nxt);
        const char* nA = has_next ? (const char*)g.A + (size_t)nxt.pm * tstep : cA; const char* nB = has_next ? (const char*)g.Bt + (size_t)nxt.pn * tstep : cB;
        for (int t = 0; t < nt; t += 2) {
            const bool last = (t == nt - 2);
            const char* a1 = cA + (size_t)(t + 1) * kstep;
            const char* a2 = last ? nA : cA + (size_t)(t + 2) * kstep; const char* b2 = last ? nB : cB + (size_t)(t + 2) * kstep;
            const char* a3 = a2 + kstep; const char* b3 = b2 + kstep;
            if (last && has_next) S.a_ready(nxt);
            if constexpr (SP2) {
            PG8_LDB(B0, 0, 0); PG8_LDB(B1, 0, 1); PG8_SCHED; PG8_LDA(At, 0, 0); PG8_STAGE(PG8_SA(1, 1), a1 + hstep, voffA);
            PG8_WAIT_V(8); PG8_WAIT_L(0); PG8_BAR; PG8_MMA(0, 0, At, B0); PG8_MMA(0, 1, At, B1); PG8_BAR; PG8_SCHED;
            PG8_LDA(At, 0, 1); PG8_STAGE(PG8_SB(0, 0), b2, voffB); PG8_STAGE(PG8_SB(0, 1), b2 + hstep, voffB); PG8_STAGE(PG8_SA(0, 0), a2, voffA);
            PG8_WAIT_V(8); PG8_WAIT_L(0); PG8_BAR; PG8_MMA(1, 0, At, B0); PG8_MMA(1, 1, At, B1); PG8_BAR; PG8_SCHED;
            PG8_LDB(B0, 1, 0); PG8_LDB(B1, 1, 1); PG8_SCHED; PG8_LDA(At, 1, 0); PG8_STAGE(PG8_SA(0, 1), a2 + hstep, voffA);
            PG8_WAIT_V(8); PG8_WAIT_L(0); PG8_BAR; PG8_MMA(0, 0, At, B0); PG8_MMA(0, 1, At, B1); PG8_BAR; PG8_SCHED;
            PG8_LDA(At, 1, 1); PG8_STAGE(PG8_SB(1, 0), b3, voffB); PG8_STAGE(PG8_SB(1, 1), b3 + hstep, voffB); PG8_STAGE(PG8_SA(1, 0), a3, voffA);
            PG8_WAIT_V(8); PG8_WAIT_L(0); PG8_BAR; PG8_MMA(1, 0, At, B0); PG8_MMA(1, 1, At, B1); PG8_BAR; PG8_SCHED;
            } else {
            PG8_LDB(B0, 0, 0); PG8_SCHED; PG8_LDA(At, 0, 0); PG8_STAGE(PG8_SA(1, 1), a1 + hstep, voffA);
            PG8_WAIT_L(8); PG8_BAR; PG8_WAIT_L(0); PG8_MMA(0, 0, At, B0); PG8_BAR; PG8_SCHED;
            PG8_LDB(B1, 0, 1); PG8_STAGE(PG8_SB(0, 0), b2, voffB);
            PG8_BAR; PG8_WAIT_L(0); PG8_MMA(0, 1, At, B1); PG8_BAR;
            PG8_LDA(At, 0, 1); PG8_STAGE(PG8_SA(0, 0), a2, voffA);
            PG8_BAR; PG8_WAIT_L(0); PG8_MMA(1, 0, At, B0); PG8_BAR; PG8_SCHED;
            PG8_STAGE(PG8_SB(0, 1), b2 + hstep, voffB);
            PG8_WAIT_V(6); PG8_BAR; PG8_MMA(1, 1, At, B1); PG8_BAR;
            PG8_LDB(B0, 1, 0); PG8_SCHED; PG8_LDA(At, 1, 0); PG8_STAGE(PG8_SA(0, 1), a2 + hstep, voffA);
            PG8_WAIT_L(8); PG8_BAR; PG8_WAIT_L(0); PG8_MMA(0, 0, At, B0); PG8_BAR; PG8_SCHED;
            PG8_LDB(B1, 1, 1); PG8_STAGE(PG8_SB(1, 0), b3, voffB);
            PG8_BAR; PG8_WAIT_L(0); PG8_MMA(0, 1, At, B1); PG8_BAR;
            PG8_LDA(At, 1, 1); PG8_STAGE(PG8_SA(1, 0), a3, voffA);
            PG8_BAR; PG8_WAIT_L(0); PG8_MMA(1, 0, At, B0); PG8_BAR; PG8_SCHED;
            PG8_STAGE(PG8_SB(1, 1), b3 + hstep, voffB);
            PG8_WAIT_V(6); PG8_BAR; PG8_MMA(1, 1, At, B1); PG8_BAR;
            }
        }
        if constexpr (ALIGN_EPI) { if (wr == 0) PG8_BAR; }
        if constexpr (!Epi::AFTER_DRAIN) { E(acc, cur, wr, wc, fr, fq); S.done(cur); }
        if (!has_next) break;
#pragma unroll
        for (int a = 0; a < 2; ++a)
#pragma unroll
            for (int b = 0; b < 2; ++b)
#pragma unroll
                for (int m = 0; m < 4; ++m)
#pragma unroll
                    for (int n = 0; n < 2; ++n) acc[a][b][m][n] = (f32x4){0.f, 0.f, 0.f, 0.f};
        cur = nxt; cA = nA; cB = nB; ++ui;
        if constexpr (ALIGN_EPI) { if (wr == 1) PG8_BAR; }
    }
    PG8_WAIT_V(0);
    if constexpr (!ALIGN_EPI) { if (wr == 0) PG8_BAR; }
    PG8_BAR;
    if constexpr (Epi::AFTER_DRAIN) { E.fused(acc, cur, wr, wc, fr, fq, lds, wid, lane); S.done(cur); }
#undef PG8_SA
#undef PG8_SB
#undef PG8_STAGE
#undef PG8_LDA
#undef PG8_LDB
#undef PG8_MMA
#undef PG8_WAIT_V
#undef PG8_WAIT_L
#undef PG8_BAR
#undef PG8_SCHED
}
}
namespace att {
using bf16 = __hip_bfloat16;
constexpr int   D = 128, NW = 8, QBLK = 32, KVBLK = 64;
constexpr float SCALE = 0.088388347648318440f;
constexpr float THR = 8.f;
constexpr int SDEPTH = 2;
constexpr int LDQ = 2560, LDK = 2560, LDO = 2048;
constexpr size_t SHM_V = KVBLK * D * 2, SHM_K = KVBLK * D * 2, SHM_ATTN = 2 * SHM_V + 2 * SHM_K + NW * 64 * 4;
using bf16x8 = __attribute__((ext_vector_type(8))) short;
using s16x4  = __attribute__((ext_vector_type(4))) short;
using f32x16 = __attribute__((ext_vector_type(16))) float;
using f32x8  = __attribute__((ext_vector_type(8))) float;
using u32x4  = __attribute__((ext_vector_type(4))) unsigned;
#define KSWZ(row, colB) ((row) * 256 + ((colB) ^ (((row) & 7) << 4)))
#define SBAR() __builtin_amdgcn_sched_barrier(0)
__device__ __forceinline__ int crow(int r, int hi) { return (r & 3) + 8 * (r >> 2) + 4 * hi; }
__device__ __forceinline__ unsigned cvtpk(float lo, float hi) {
  unsigned r; asm volatile("v_cvt_pk_bf16_f32 %0, %1, %2" : "=v"(r) : "v"(lo), "v"(hi)); return r;
}
template <typename TIn> struct Stage;
template <> struct Stage<bf16>  { using T = bf16x8;
  __device__ static __forceinline__ T ld8(const bf16* p) { return *reinterpret_cast<const bf16x8*>(p); }
  __device__ static __forceinline__ bf16x8 tobf(T x) { return x; } };
template <> struct Stage<float> { using T = f32x8;
  __device__ static __forceinline__ T ld8(const float* p) { return *reinterpret_cast<const f32x8*>(p); }
  __device__ static __forceinline__ bf16x8 tobf(T x) {
    u32x4 w = {cvtpk(x[0], x[1]), cvtpk(x[2], x[3]), cvtpk(x[4], x[5]), cvtpk(x[6], x[7])}; return *reinterpret_cast<bf16x8*>(&w); } };

__device__ __forceinline__ void partialSM(f32x16& p0, f32x16& p1, float& m_reg, float& mn, float& alpha) {
  constexpr float C = SCALE * 1.4426950408889634f;
  float pmax = p0[0]; for (int r = 1; r < 16; ++r) pmax = fmaxf(pmax, p0[r]); for (int r = 0; r < 16; ++r) pmax = fmaxf(pmax, p1[r]);
  { auto rr = __builtin_amdgcn_permlane32_swap(__float_as_uint(pmax), __float_as_uint(pmax), false, false);
    pmax = fmaxf(__uint_as_float(rr[0]), __uint_as_float(rr[1])); }
  if (__builtin_expect(__all(pmax - m_reg <= THR / SCALE), 1)) { mn = m_reg; alpha = 1.f; }
  else { mn = fmaxf(m_reg, pmax); alpha = __builtin_amdgcn_exp2f((m_reg - mn) * C); m_reg = mn; }
  float mnC = -mn * C;
  for (int r = 0; r < 16; ++r) p0[r] = fmaf(p0[r], C, mnC); for (int r = 0; r < 16; ++r) p1[r] = fmaf(p1[r], C, mnC);
  for (int r = 0; r < 16; ++r) p0[r] = __builtin_amdgcn_exp2f(p0[r]);
}
__device__ __forceinline__ void finishSM(f32x16& p0, f32x16& p1, float alpha, float& l_reg, bf16x8& pa0, bf16x8& pa1, bf16x8& pa2, bf16x8& pa3) {
  for (int r = 0; r < 16; ++r) p1[r] = __builtin_amdgcn_exp2f(p1[r]);
  float ps = 0; for (int r = 0; r < 16; ++r) ps += p0[r]; for (int r = 0; r < 16; ++r) ps += p1[r];
  { auto rr = __builtin_amdgcn_permlane32_swap(__float_as_uint(ps), __float_as_uint(ps), false, false);
    ps = __uint_as_float(rr[0]) + __uint_as_float(rr[1]); }
  l_reg = l_reg * alpha + ps;
#define PK4(P, BASE, OUT) do { unsigned a0 = cvtpk(P[BASE + 0], P[BASE + 1]), a1 = cvtpk(P[BASE + 2], P[BASE + 3]);   \
    unsigned b0 = cvtpk(P[BASE + 4], P[BASE + 5]), b1 = cvtpk(P[BASE + 6], P[BASE + 7]);                              \
    auto r0 = __builtin_amdgcn_permlane32_swap(a0, b0, false, false); auto r1 = __builtin_amdgcn_permlane32_swap(a1, b1, false, false); \
    u32x4 w = {r0[0], r1[0], r0[1], r1[1]}; OUT = *reinterpret_cast<bf16x8*>(&w); } while (0)
  PK4(p0, 0, pa0); PK4(p0, 8, pa1); PK4(p1, 0, pa2); PK4(p1, 8, pa3);
#undef PK4
}
__device__ __forceinline__ void partialSM2(f32x16& p0, f32x16& p1, float mnC) {
  constexpr float C = SCALE * 1.4426950408889634f;
  for (int r = 0; r < 16; ++r) p0[r] = fmaf(p0[r], C, mnC); for (int r = 0; r < 16; ++r) p1[r] = fmaf(p1[r], C, mnC);
  for (int r = 0; r < 16; ++r) p0[r] = __builtin_amdgcn_exp2f(p0[r]);
}
__device__ __forceinline__ void finishSM2(f32x16& p0, f32x16& p1, float& l_reg, bf16x8& pa0, bf16x8& pa1, bf16x8& pa2, bf16x8& pa3) {
  for (int r = 0; r < 16; ++r) p1[r] = __builtin_amdgcn_exp2f(p1[r]);
  float ps = 0; for (int r = 0; r < 16; ++r) ps += p0[r]; for (int r = 0; r < 16; ++r) ps += p1[r];
  { auto rr = __builtin_amdgcn_permlane32_swap(__float_as_uint(ps), __float_as_uint(ps), false, false);
    ps = __uint_as_float(rr[0]) + __uint_as_float(rr[1]); }
  l_reg += ps;
#define PK4(P, BASE, OUT) do { unsigned a0 = cvtpk(P[BASE + 0], P[BASE + 1]), a1 = cvtpk(P[BASE + 2], P[BASE + 3]);   \
    unsigned b0 = cvtpk(P[BASE + 4], P[BASE + 5]), b1 = cvtpk(P[BASE + 6], P[BASE + 7]);                              \
    auto r0 = __builtin_amdgcn_permlane32_swap(a0, b0, false, false); auto r1 = __builtin_amdgcn_permlane32_swap(a1, b1, false, false); \
    u32x4 w = {r0[0], r1[0], r0[1], r1[1]}; OUT = *reinterpret_cast<bf16x8*>(&w); } while (0)
  PK4(p0, 0, pa0); PK4(p0, 8, pa1); PK4(p1, 0, pa2); PK4(p1, 8, pa3);
#undef PK4
}
__device__ __forceinline__ void qkt(f32x16& p0, f32x16& p1, const bf16* Ks, const bf16x8* qr, int r32, int hi) {
  p0 = f32x16{}; p1 = f32x16{};
  for (int d0 = 0; d0 < 8; ++d0) { int cb = (d0 * 16 + hi * 8) * 2;
    bf16x8 b0 = *reinterpret_cast<const bf16x8*>((const char*)Ks + KSWZ(r32, cb));
    bf16x8 b1 = *reinterpret_cast<const bf16x8*>((const char*)Ks + KSWZ(32 + r32, cb));
    p0 = __builtin_amdgcn_mfma_f32_32x32x16_bf16(b0, qr[d0], p0, 0, 0, 0);
    p1 = __builtin_amdgcn_mfma_f32_32x32x16_bf16(b1, qr[d0], p1, 0, 0, 0); }
}
__device__ __forceinline__ int v_st(int k, int c) { const int kk = (k & ~0xC) | ((k & 4) << 1) | ((k & 8) >> 1); return ((kk >> 3) * 4 + (c >> 5)) * 512 + ((kk & 7) * 32 + (c & 31)) * 2; }
__device__ __forceinline__ int v_rd_base(int lane) { return ((lane & 3) << 3) | (((lane >> 2) & 3) << 6) | (((lane >> 4) & 1) << 5) | (((lane >> 5) & 1) << 8); }
constexpr int v_rd_off(int d0, int ks, int half) { return d0 * 512 + ks * 4096 + half * 2048; }
template <int OFF> __device__ __forceinline__ s16x4 tr_read(int vb) {
  s16x4 r; asm volatile("ds_read_b64_tr_b16 %0, %1 offset:%2" : "=&v"(r) : "v"(vb), "i"(OFF) : "memory"); return r;
}
template <int D0> __device__ __forceinline__ void pv_one(f32x16& od, int vb, bf16x8 pa0, bf16x8 pa1, bf16x8 pa2, bf16x8 pa3) {
  const s16x4 l0 = tr_read<v_rd_off(D0, 0, 0)>(vb), h0 = tr_read<v_rd_off(D0, 0, 1)>(vb), l1 = tr_read<v_rd_off(D0, 1, 0)>(vb), h1 = tr_read<v_rd_off(D0, 1, 1)>(vb);
  const s16x4 l2 = tr_read<v_rd_off(D0, 2, 0)>(vb), h2 = tr_read<v_rd_off(D0, 2, 1)>(vb), l3 = tr_read<v_rd_off(D0, 3, 0)>(vb), h3 = tr_read<v_rd_off(D0, 3, 1)>(vb);
  asm volatile("s_waitcnt lgkmcnt(0)" ::: "memory"); SBAR();
#define PK(L, H) (bf16x8){L[0], L[1], L[2], L[3], H[0], H[1], H[2], H[3]}
  od = __builtin_amdgcn_mfma_f32_32x32x16_bf16(pa0, PK(l0, h0), od, 0, 0, 0);
  od = __builtin_amdgcn_mfma_f32_32x32x16_bf16(pa1, PK(l1, h1), od, 0, 0, 0);
  od = __builtin_amdgcn_mfma_f32_32x32x16_bf16(pa2, PK(l2, h2), od, 0, 0, 0);
  od = __builtin_amdgcn_mfma_f32_32x32x16_bf16(pa3, PK(l3, h3), od, 0, 0, 0);
#undef PK
}
__device__ __forceinline__ void pv_d0(f32x16* o, int vb, bf16x8 pa0, bf16x8 pa1, bf16x8 pa2, bf16x8 pa3) {
  pv_one<0>(o[0], vb, pa0, pa1, pa2, pa3); pv_one<1>(o[1], vb, pa0, pa1, pa2, pa3); pv_one<2>(o[2], vb, pa0, pa1, pa2, pa3); pv_one<3>(o[3], vb, pa0, pa1, pa2, pa3);
}
template <typename TQ>
__device__ __forceinline__ void attn_dense_body(const TQ* __restrict__ Qb, const bf16* __restrict__ Kh, const bf16* __restrict__ Vh,
                                                unsigned* __restrict__ Ob, int seq, char* lds, const float* __restrict__ gq, int tq0, const float* __restrict__ gk, const int mk_wave) {
  using St = Stage<bf16>; using SQ = Stage<TQ>;
  const int lane = (int)__builtin_amdgcn_mbcnt_hi(~0u, __builtin_amdgcn_mbcnt_lo(~0u, 0u)), wid = mk_wave, tid = wid * 64 + lane, r32 = lane & 31, hi = lane >> 5;
  bf16* V_lds = (bf16*)lds; bf16* K_lds = (bf16*)(lds + 2 * SHM_V);
  float* ws = (float*)(lds + 2 * SHM_V + 2 * SHM_K) + wid * 64; float* li_l = ws; float* al_l = ws + 32;
  float l_reg = 0; f32x16 o[4] = {}; bf16x8 qr[8];
  float mnC;
  { float a = fmaxf(fabsf(gq[lane]), fabsf(gq[lane + 64])), b = fmaxf(fabsf(gk[lane]), fabsf(gk[lane + 64]));
#pragma unroll
    for (int o_ = 1; o_ < 64; o_ <<= 1) { a = fmaxf(a, __shfl_xor(a, o_)); b = fmaxf(b, __shfl_xor(b, o_)); }
    mnC = -(128.0f * a * b) * (SCALE * 1.4426950408889634f); }
  const TQ* Qw = Qb + (long)(wid * QBLK + r32) * LDQ + hi * 8;
#pragma unroll
  for (int d0 = 0; d0 < 8; ++d0) qr[d0] = SQ::tobf(SQ::ld8(Qw + d0 * 16));
  {
    float ss = 0.f;
#pragma unroll
    for (int d0 = 0; d0 < 8; ++d0)
#pragma unroll
      for (int j = 0; j < 8; ++j) { const float x = __uint_as_float(((unsigned)(unsigned short)qr[d0][j]) << 16); ss += x * x; }
    ss += __shfl_xor(ss, 32);
    const float rstd = 1.0f / sqrtf(ss * (1.f / 128.f) + 1e-6f);
    const int tq = tq0 + wid * QBLK + r32;
    int hio = hi * 8; asm volatile("" : "+v"(hio));
#pragma unroll
    for (int ax = 0; ax < 2; ++ax) { const float pos = (float)(ax == 0 ? (tq >> 6) : (tq & 63));
#pragma unroll
      for (int dd = 0; dd < 2; ++dd) { const int da = ax * 4 + dd, db = da + 2;
        const f32x8 ga = *reinterpret_cast<const f32x8*>(gq + da * 16 + hi * 8), gb = *reinterpret_cast<const f32x8*>(gq + db * 16 + hi * 8);
        float oa[8], ob[8];
#pragma unroll
        for (int j = 0; j < 8; ++j) { const float rev = pos * (__builtin_amdgcn_exp2f(-(float)(dd * 16 + hio + j) * 0.41524101186092029f) * 0.15915494309189535f);
          const float cs = __builtin_amdgcn_cosf(rev), sn = __builtin_amdgcn_sinf(rev);
          const float x1 = __uint_as_float(((unsigned)(unsigned short)qr[da][j]) << 16) * rstd * ga[j], x2 = __uint_as_float(((unsigned)(unsigned short)qr[db][j]) << 16) * rstd * gb[j];
          oa[j] = x1 * cs - x2 * sn; ob[j] = x2 * cs + x1 * sn; }
        u32x4 wa = {cvtpk(oa[0], oa[1]), cvtpk(oa[2], oa[3]), cvtpk(oa[4], oa[5]), cvtpk(oa[6], oa[7])}, wb = {cvtpk(ob[0], ob[1]), cvtpk(ob[2], ob[3]), cvtpk(ob[4], ob[5]), cvtpk(ob[6], ob[7])};
        qr[da] = *reinterpret_cast<bf16x8*>(&wa); qr[db] = *reinterpret_cast<bf16x8*>(&wb);
        asm volatile("" : "+v"(qr[da]), "+v"(qr[db])); } }
  }
  const int sr = tid >> 4, sc = (tid & 15) * 8, vst0 = v_st(sr, sc), vst1 = v_st(32 + sr, sc);
  const int vb0 = (int)(uintptr_t)V_lds + v_rd_base(lane);
  struct { typename St::T vs0, vs1, ks0, ks1; } sr_[SDEPTH];
#define SLOAD(i, k0) do { sr_[i].vs0 = St::ld8(&Vh[(long)((k0) + sr) * LDK + sc]); sr_[i].vs1 = St::ld8(&Vh[(long)((k0) + 32 + sr) * LDK + sc]); \
    sr_[i].ks0 = St::ld8(&Kh[(long)((k0) + sr) * LDK + sc]); sr_[i].ks1 = St::ld8(&Kh[(long)((k0) + 32 + sr) * LDK + sc]); } while (0)
#define SWRITE(b, i) do { *(bf16x8*)((char*)V_lds + (b) * SHM_V + vst0) = St::tobf(sr_[i].vs0);          \
    *(bf16x8*)((char*)V_lds + (b) * SHM_V + vst1) = St::tobf(sr_[i].vs1); int kc = sc * 2;               \
    *(bf16x8*)((char*)K_lds + (b) * SHM_K + KSWZ(sr, kc)) = St::tobf(sr_[i].ks0);                       \
    *(bf16x8*)((char*)K_lds + (b) * SHM_K + KSWZ(32 + sr, kc)) = St::tobf(sr_[i].ks1); } while (0)
#define SWAIT() do { if constexpr (SDEPTH == 2) asm volatile("s_waitcnt vmcnt(4)" ::: "memory"); else asm volatile("s_waitcnt vmcnt(0)" ::: "memory"); } while (0)
#define RESC(a) do { if (__any((a) < 1.f)) { if (hi == 0) al_l[r32] = (a); asm volatile("s_waitcnt lgkmcnt(0)" ::: "memory"); \
    for (int d = 0; d < 4; ++d) for (int r = 0; r < 16; ++r) o[d][r] *= al_l[crow(r, hi)]; } } while (0)
  f32x16 pA0, pA1, pB0, pB1; float mnA, mnB, alA, alB; bf16x8 pa0, pa1, pa2, pa3; const int NT = seq / KVBLK;
  constexpr int SE = 0, SO = SDEPTH - 1;
  SLOAD(SE, 0); asm volatile("s_waitcnt vmcnt(0)" ::: "memory"); SWRITE(0, SE); __syncthreads();
  qkt(pA0, pA1, K_lds, qr, r32, hi); partialSM2(pA0, pA1, mnC);
  SLOAD(SO, KVBLK); if constexpr (SDEPTH == 2) { if (2 < NT) SLOAD(SE, 2 * KVBLK); }
  SWAIT(); SWRITE(1, SO); __syncthreads();
  for (int j = 1; j + 1 < NT; j += 2) {
    SBAR(); qkt(pB0, pB1, (bf16*)((char*)K_lds + SHM_K), qr, r32, hi);
    finishSM2(pA0, pA1, l_reg, pa0, pa1, pa2, pa3); SBAR();
    SLOAD(SO, (j + SDEPTH) * KVBLK); SBAR();
    pv_d0(o, vb0, pa0, pa1, pa2, pa3); partialSM2(pB0, pB1, mnC);
    __syncthreads(); SWAIT(); SWRITE(0, SE);
    __syncthreads();
    SBAR(); qkt(pA0, pA1, K_lds, qr, r32, hi);
    finishSM2(pB0, pB1, l_reg, pa0, pa1, pa2, pa3); SBAR();
    if (SDEPTH == 1 || j + 3 < NT) SLOAD(SE, (j + 1 + SDEPTH) * KVBLK); SBAR();
    pv_d0(o, vb0 + (int)SHM_V, pa0, pa1, pa2, pa3); partialSM2(pA0, pA1, mnC);
    __syncthreads(); SWAIT(); SWRITE(1, SO);
    __syncthreads();
  }
  SBAR(); qkt(pB0, pB1, (bf16*)((char*)K_lds + SHM_K), qr, r32, hi);
  finishSM2(pA0, pA1, l_reg, pa0, pa1, pa2, pa3); SBAR();
  pv_d0(o, vb0, pa0, pa1, pa2, pa3); partialSM2(pB0, pB1, mnC);
  __syncthreads();
  finishSM2(pB0, pB1, l_reg, pa0, pa1, pa2, pa3); SBAR();
  pv_d0(o, vb0 + (int)SHM_V, pa0, pa1, pa2, pa3);
  int lane_e = lane; asm volatile("" : "+v"(lane_e));
  const int r32e = lane_e & 31, hie = lane_e >> 5;
  if (hie == 0) li_l[r32e] = l_reg; asm volatile("s_waitcnt lgkmcnt(0)" ::: "memory");
  float rli[16];
#pragma unroll
  for (int r = 0; r < 16; ++r) rli[r] = __builtin_amdgcn_rcpf(li_l[crow(r, hie)]);
  unsigned* Ow = Ob + (long)(wid * QBLK) * (LDO / 2);
#pragma unroll
  for (int r = 0; r < 16; r += 2) {
#pragma unroll
    for (int d0 = 0; d0 < 4; ++d0) {
      const float x = o[d0][r] * rli[r], y = o[d0][r + 1] * rli[r + 1];
      const float snd = (lane_e & 1) ? x : y; const float rcv = __shfl_xor(snd, 1);
      const unsigned w = (lane_e & 1) ? cvtpk(rcv, y) : cvtpk(x, rcv);
      const int orow = crow((lane_e & 1) ? r + 1 : r, hie);
      Ow[(long)orow * (LDO / 2) + ((d0 * 32 + (r32e & ~1)) >> 1)] = w; } }
  __syncthreads();
#undef SLOAD
#undef SWRITE
#undef SWAIT
#undef RESC
}
}

#ifndef MK_PER_PHASE
#define MK_PER_PHASE 0
#endif
#define LAS __attribute__((address_space(3)))
typedef unsigned short bf16r;
typedef float f32x4g __attribute__((ext_vector_type(4)));
typedef unsigned u32x4g __attribute__((ext_vector_type(4)));
typedef unsigned u32x2g __attribute__((ext_vector_type(2)));
constexpr size_t MiB = 1u << 20;
constexpr size_t WS_WIN = 2 * MiB, WS_WPOOL = 12 * MiB, WS_WOUT = 13 * MiB, WS_WUP = 21 * MiB, WS_WDOWN = 65 * MiB;
constexpr size_t WS_XN = 96 * MiB;
constexpr size_t WS_Z = 288 * MiB;
constexpr size_t WS_D = 528 * MiB;
constexpr size_t WS_AM = 624 * MiB;
constexpr size_t WS_ACT = 288 * MiB;
constexpr size_t WS_HS = 816 * MiB, WS_HV = 825 * MiB, WS_HG = 834 * MiB, WS_SS = 843 * MiB, WS_RSTD = 845 * MiB, WS_END = 846 * MiB;
static_assert(WS_WDOWN + (size_t)2048 * 5632 * 2 <= WS_XN && WS_XN + (size_t)M_ALL * 2048 * 2 <= WS_Z && WS_Z + (size_t)M_ALL * 2560 * 2 <= WS_D && WS_D + (size_t)M_ALL * 1024 * 2 <= WS_AM &&
              WS_AM + (size_t)M_ALL * 2048 * 2 <= WS_HS && WS_ACT + (size_t)M_ALL * 5632 * 2 <= WS_HS && WS_HS + (size_t)192 * 2 * 5632 * 4 <= WS_HV, "d_ws map");
constexpr int RING_BYTES = 131072, XCH_OFF = RING_BYTES, XBST_OFF = RING_BYTES + 12288, LDS_BYTES = 147456;
constexpr size_t WS_BAR = 0;
constexpr int N_PHASES = 9;

__device__ __forceinline__ float wave_sum(float v) {
#pragma unroll
    for (int o = 1; o < 64; o <<= 1) v += __shfl_xor(v, o);
    return v;
}
__device__ __forceinline__ float bf_lo(unsigned w) { return __uint_as_float(w << 16); }
__device__ __forceinline__ float bf_hi(unsigned w) { return __uint_as_float(w & 0xffff0000u); }
#define LDS_WAIT() asm volatile("s_waitcnt lgkmcnt(0)" ::: "memory")

template <int MODE> __device__ __forceinline__ void transpose_item(const float* W, int K, int N, bf16r* WT, int row_off, LAS float* scr, int item, int lane, const float* kscale = nullptr) {
    const int nblk = N / 32, kb = item / nblk, nb = item % nblk, k0 = 64 * kb, n0 = 32 * nb;
    float tv[32];
#pragma unroll
    for (int i = 0; i < 32; ++i) { const int kk = 2 * i + (lane >> 5); tv[i] = W[(size_t)(k0 + kk) * N + n0 + (lane & 31)]; }
    if (MODE == 1) {
        float ks[32];
#pragma unroll
        for (int i = 0; i < 32; ++i) ks[i] = kscale[k0 + 2 * i + (lane >> 5)];
#pragma unroll
        for (int i = 0; i < 32; ++i) tv[i] *= ks[i];
    }
#pragma unroll
    for (int i = 0; i < 32; ++i) { const int kk = 2 * i + (lane >> 5); scr[kk * 33 + (lane & 31)] = tv[i]; }
    LDS_WAIT(); asm volatile("" ::: "memory");
    int d0 = row_off + n0;
    if (MODE == 1) d0 = n0 < 5632 ? 256 * (n0 / 128) + (n0 % 128) : 256 * ((n0 - 5632) / 128) + 128 + ((n0 - 5632) % 128);
    const int c = lane & 7;
#pragma unroll
    for (int j = 0; j < 4; ++j) { const int n = (lane >> 3) + 8 * j; const LAS float* s = scr + (8 * c) * 33 + n;
        u32x4g o; o.x = pg8::cvt_pk_bf16(s[0 * 33], s[1 * 33]); o.y = pg8::cvt_pk_bf16(s[2 * 33], s[3 * 33]); o.z = pg8::cvt_pk_bf16(s[4 * 33], s[5 * 33]); o.w = pg8::cvt_pk_bf16(s[6 * 33], s[7 * 33]);
        *(u32x4g*)(WT + (size_t)(d0 + n) * K + k0 + 8 * c) = o; }
    LDS_WAIT(); asm volatile("" ::: "memory");
}
__device__ __forceinline__ void rms_rows_to_bf16(const float* x_p, const float* x_s, const float* g, bf16r* xn, int gw, int NGW, int lane) {
    f32x4g gv[8], cur[8], nxt[8];
    const f32x4g* gr = (const f32x4g*)g + lane;
#pragma unroll
    for (int j = 0; j < 8; ++j) gv[j] = gr[64 * j];
    int m = gw;
    if (m < M_ALL) { const f32x4g* xr = (const f32x4g*)(m < M_P ? x_p + (size_t)m * 2048 : x_s + (size_t)(m - M_P) * 2048) + lane;
#pragma unroll
        for (int j = 0; j < 8; ++j) cur[j] = xr[64 * j]; }
    for (; m < M_ALL; m += NGW) {
        const int mn = m + NGW;
        if (mn < M_ALL) { const f32x4g* xr = (const f32x4g*)(mn < M_P ? x_p + (size_t)mn * 2048 : x_s + (size_t)(mn - M_P) * 2048) + lane;
#pragma unroll
            for (int j = 0; j < 8; ++j) nxt[j] = xr[64 * j]; }
        float s = 0.f;
#pragma unroll
        for (int j = 0; j < 8; ++j) s += (cur[j].x * cur[j].x + cur[j].y * cur[j].y) + (cur[j].z * cur[j].z + cur[j].w * cur[j].w);
        const float rstd = 1.0f / sqrtf(wave_sum(s) * (1.f / 2048.f) + RMS_EPS);
        u32x2g* o8 = (u32x2g*)(xn + (size_t)m * 2048) + lane;
#pragma unroll
        for (int j = 0; j < 8; ++j) { const f32x4g y = cur[j] * rstd * gv[j]; u32x2g w; w.x = pg8::cvt_pk_bf16(y.x, y.y); w.y = pg8::cvt_pk_bf16(y.z, y.w); o8[64 * j] = w; }
#pragma unroll
        for (int j = 0; j < 8; ++j) cur[j] = nxt[j];
    }
}
template <int HW> __device__ __forceinline__ void pool_item(const bf16r* vcol  , int t0, int L, const float* sc8, bf16r* ocol  ) {
    constexpr int RB = 8, NR = 2 * HW + RB - 1;
    u32x4g rows[NR];
#pragma unroll
    for (int j = 0; j < NR; ++j) { const int t = t0 - HW + j; rows[j] = (t >= 0 && t < L) ? *(const u32x4g*)(vcol + (size_t)t * N_IN) : (u32x4g){0u, 0u, 0u, 0u}; }
    const f32x4g sa = *(const f32x4g*)sc8, sb = *(const f32x4g*)(sc8 + 4);
    float S[8] = {0.f, 0.f, 0.f, 0.f, 0.f, 0.f, 0.f, 0.f};
#define POOL_ACC(R, SGN) do { S[0] += SGN bf_lo(R.x); S[1] += SGN bf_hi(R.x); S[2] += SGN bf_lo(R.y); S[3] += SGN bf_hi(R.y); S[4] += SGN bf_lo(R.z); S[5] += SGN bf_hi(R.z); S[6] += SGN bf_lo(R.w); S[7] += SGN bf_hi(R.w); } while (0)
#pragma unroll
    for (int j = 0; j < 2 * HW; ++j) POOL_ACC(rows[j], +);
#pragma unroll
    for (int i = 0; i < RB; ++i) { const int t = t0 + i; const int lo = t - HW < 0 ? 0 : t - HW, hi = t + HW > L ? L : t + HW; const float rc = 1.0f / (float)(hi - lo);
        const u32x4g U = rows[i + HW];
        u32x4g O; O.x = pg8::cvt_pk_bf16((S[0] * rc - bf_lo(U.x)) * sa.x, (S[1] * rc - bf_hi(U.x)) * sa.y); O.y = pg8::cvt_pk_bf16((S[2] * rc - bf_lo(U.y)) * sa.z, (S[3] * rc - bf_hi(U.y)) * sa.w);
        O.z = pg8::cvt_pk_bf16((S[4] * rc - bf_lo(U.z)) * sb.x, (S[5] * rc - bf_hi(U.z)) * sb.y); O.w = pg8::cvt_pk_bf16((S[6] * rc - bf_lo(U.w)) * sb.z, (S[7] * rc - bf_hi(U.w)) * sb.w);
        *(u32x4g*)(ocol + (size_t)i * 2048) = O;
        if (i < RB - 1) { POOL_ACC(rows[i + 2 * HW], +); POOL_ACC(rows[i], -); } }
#undef POOL_ACC
}
__device__ __forceinline__ void fold_pool_item(const float* w_in, const float* w_pool, bf16r* WT, LAS float* scr, int item, int lane) {
    const int g = item >> 9, kb = (item >> 2) & 127, db = item & 3, k0 = kb * 16, d0 = db * 64;
    f32x4g av[16];
#pragma unroll
    for (int kk = 0; kk < 16; ++kk) av[kk] = *(const f32x4g*)(w_in + (size_t)(k0 + kk) * N_IN + 1536 + g * 256 + lane * 4);
#pragma unroll
    for (int kk = 0; kk < 16; ++kk) *(LAS f32x4g*)(scr + kk * 256 + lane * 4) = av[kk];
    LDS_WAIT(); asm volatile("" ::: "memory");
    const float* bp = w_pool + (size_t)g * 65536 + d0 + lane;
    float acc[16];
#pragma unroll
    for (int kk = 0; kk < 16; ++kk) acc[kk] = 0.f;
#pragma unroll 2
    for (int c = 0; c < 256; c += 4) {
        const float b0 = bp[(size_t)(c + 0) * 256], b1 = bp[(size_t)(c + 1) * 256], b2 = bp[(size_t)(c + 2) * 256], b3 = bp[(size_t)(c + 3) * 256];
#pragma unroll
        for (int kk = 0; kk < 16; ++kk) { const f32x4g a = *(const LAS f32x4g*)(scr + kk * 256 + c); acc[kk] += a.x * b0 + a.y * b1 + a.z * b2 + a.w * b3; }
    }
    u32x4g o0, o1;
    o0.x = pg8::cvt_pk_bf16(acc[0], acc[1]); o0.y = pg8::cvt_pk_bf16(acc[2], acc[3]); o0.z = pg8::cvt_pk_bf16(acc[4], acc[5]); o0.w = pg8::cvt_pk_bf16(acc[6], acc[7]);
    o1.x = pg8::cvt_pk_bf16(acc[8], acc[9]); o1.y = pg8::cvt_pk_bf16(acc[10], acc[11]); o1.z = pg8::cvt_pk_bf16(acc[12], acc[13]); o1.w = pg8::cvt_pk_bf16(acc[14], acc[15]);
    bf16r* orow = WT + (size_t)(1536 + g * 256 + d0 + lane) * 2048 + k0;
    *(u32x4g*)orow = o0; *(u32x4g*)(orow + 8) = o1;
    LDS_WAIT(); asm volatile("" ::: "memory");
}
#define XB_TMO      128
#define XB_XCNT(j)  (256  + 64 * (j))
#define XB_XSUB(j)  (1280 + 64 * (j))
#define XB_XGEN(j)  (2304 + 64 * (j))
#define XB_TOP      3328
#define XB_TOPGEN   3392
#define XCD_BAR_WORDS 3456
#define XB_SPIN_CAP (1u << 18)

__device__ __forceinline__ unsigned xb_ld(unsigned* p)              { return __hip_atomic_load(p, __ATOMIC_RELAXED, __HIP_MEMORY_SCOPE_AGENT); }
__device__ __forceinline__ unsigned xb_add(unsigned* p, unsigned v) { return __hip_atomic_fetch_add(p, v, __ATOMIC_RELAXED, __HIP_MEMORY_SCOPE_AGENT); }
__device__ __forceinline__ unsigned xb_xcc_id() { return (unsigned)__builtin_amdgcn_s_getreg((3 << 11) | 20) & 0xFu; }
#define XB_SPIN(cond, bar) do { unsigned _sp = 0; while (cond) { __builtin_amdgcn_s_sleep(1); \
    if ((++_sp & 255u) == 0u) { if (xb_ld(&(bar)[XB_TMO])) break; if (_sp > XB_SPIN_CAP) { atomicAdd(&(bar)[XB_TMO], 1u); break; } } } } while (0)

struct XcdBarrier {
    unsigned* bar; unsigned x;
    volatile __attribute__((address_space(3))) unsigned* st;
};

__device__ __forceinline__ XcdBarrier xcd_barrier_post(unsigned* bar, volatile __attribute__((address_space(3))) unsigned* st, bool leader) {
    XcdBarrier b; b.bar = bar; b.x = xb_xcc_id(); b.st = st;
    if (leader) (void)xb_add(&bar[XB_XCNT(b.x)], 1u);
    return b;
}
__device__ __forceinline__ void xcd_barrier_complete(unsigned* bar, unsigned x, unsigned& nloc, unsigned& nx) {
    const unsigned G = gridDim.x * gridDim.y * gridDim.z;
    unsigned sum, cnt, mine, sp = 0u;
    for (;;) {
        sum = 0u; cnt = 0u; mine = 0u;
#pragma unroll
        for (unsigned j = 0; j < 16; ++j) { const unsigned c = xb_ld(&bar[XB_XCNT(j)]); sum += c; cnt += (c > 0u) ? 1u : 0u; mine = (j == x) ? c : mine; }
        if (sum == G) break;
        __builtin_amdgcn_s_sleep(1);
        if ((++sp & 255u) == 0u) { if (xb_ld(&bar[XB_TMO])) break; if (sp > XB_SPIN_CAP) { atomicAdd(&bar[XB_TMO], 1u); break; } }
    }
    nloc = mine > 0u ? mine : 1u; nx = cnt > 0u ? cnt : 1u;
}

__device__ __attribute__((noinline)) void xcd_barrier(unsigned* bar_, unsigned x_, volatile __attribute__((address_space(3))) unsigned* st_, bool leader) {
    XcdBarrier b; b.bar = bar_; b.x = x_; b.st = st_;
    asm volatile("s_waitcnt vmcnt(0)" ::: "memory");
    __syncthreads();
    if (leader) {
        unsigned* bar = b.bar;
        __builtin_amdgcn_s_waitcnt(0);
        unsigned nloc = b.st[0], nx = b.st[1];
        if (nloc == 0u) { xcd_barrier_complete(bar, b.x, nloc, nx); b.st[0] = nloc; b.st[1] = nx; }
        const unsigned old = xb_add(&bar[XB_XSUB(b.x)], 1u);
        const unsigned gen = old / nloc;
        if (old + 1u == (gen + 1u) * nloc) {
            __builtin_amdgcn_fence(__ATOMIC_RELEASE, "agent");
            asm volatile("s_waitcnt vmcnt(0)" ::: "memory");
            const unsigned og = xb_add(&bar[XB_TOP], 1u);
            const unsigned tg = og / nx;
            if (og + 1u == (tg + 1u) * nx) xb_add(&bar[XB_TOPGEN], 1u);
            else XB_SPIN(xb_ld(&bar[XB_TOPGEN]) == tg, bar);
            __builtin_amdgcn_fence(__ATOMIC_ACQUIRE, "agent");
            xb_add(&bar[XB_XGEN(b.x)], 1u);
            asm volatile("s_waitcnt vmcnt(0)" ::: "memory");
        } else {
            XB_SPIN(xb_ld(&bar[XB_XGEN(b.x)]) == gen, bar);
            __builtin_amdgcn_fence(__ATOMIC_ACQUIRE, "agent");
            asm volatile("s_waitcnt vmcnt(0)" ::: "memory");
        }
    }
    __syncthreads();
}
__device__ __attribute__((noinline)) void grid_sync_fn() { cg::this_grid().sync(); }

struct Args { const float* in[14]; float* out; unsigned char* ws; int ph_lo, ph_hi; };
typedef const __attribute__((address_space(4))) Args* KArgs;
__device__ __forceinline__ KArgs kargs() { KArgs p = (KArgs)__builtin_amdgcn_kernarg_segment_ptr(); asm volatile("" : "+s"(p)); return p; }

__global__ void __launch_bounds__(512, 2) fwd_megakernel(Args args) {
    extern __shared__ __attribute__((aligned(16))) unsigned char lds[];
    const int wave = __builtin_amdgcn_readfirstlane((int)threadIdx.x >> 6);
    const int lane = (int)__builtin_amdgcn_mbcnt_hi(~0u, __builtin_amdgcn_mbcnt_lo(~0u, 0u)), tid = wave * 64 + lane;
    const int G = gridDim.x, bx = blockIdx.x;
#define KA_WS (kargs()->ws)
#define KA_IN(i) (kargs()->in[i])
#define KA_OUT (kargs()->out)
#define Win_t ((bf16r*)(KA_WS + WS_WIN))
#define Wpool_t ((bf16r*)(KA_WS + WS_WPOOL))
#define Wout_t ((bf16r*)(KA_WS + WS_WOUT))
#define Wup_t ((bf16r*)(KA_WS + WS_WUP))
#define Wdown_t ((bf16r*)(KA_WS + WS_WDOWN))
#define XN ((bf16r*)(KA_WS + WS_XN))
#define Z ((bf16r*)(KA_WS + WS_Z))
#define Dp ((bf16r*)(KA_WS + WS_D))
#define AM ((bf16r*)(KA_WS + WS_AM))
#define ACT ((bf16r*)(KA_WS + WS_ACT))
#define HS ((float*)(KA_WS + WS_HS))
#define HV ((float*)(KA_WS + WS_HV))
#define HG ((float*)(KA_WS + WS_HG))
#define SSQ ((float*)(KA_WS + WS_SS))
#define RSTD ((float*)(KA_WS + WS_RSTD))
    LAS unsigned char* ldsl = (LAS unsigned char*)lds;
    const int lo = kargs()->ph_lo, hi = kargs()->ph_hi;
#ifndef PHASE_MASK
#define PHASE_MASK 0x1ff
#endif
#define IN(k) (((PHASE_MASK >> (k)) & 1) && lo <= (k) && (k) < hi)
#ifndef PROBE_DUP
#define PROBE_DUP 0
#endif
#define NREP(k) (((PROBE_DUP >> (k)) & 1) ? 2 : 1)
#if MK_PER_PHASE
#define SEAM(k) do { } while (0)
#else
    volatile LAS unsigned* xbst = (volatile LAS unsigned*)(ldsl + XBST_OFF);
    if (tid == 0) { xbst[0] = 0u; xbst[1] = 0u; }
    const unsigned xb_x = xcd_barrier_post((unsigned*)(KA_WS + WS_BAR), xbst, tid == 0).x;
    if (hi < lo) grid_sync_fn();
#define SEAM(k) do { if (IN(k) && IN((k) + 1)) { int ln_; asm volatile("v_mbcnt_lo_u32_b32 %0, -1, 0\n\tv_mbcnt_hi_u32_b32 %0, -1, %0" : "=v"(ln_)); xcd_barrier((unsigned*)(KA_WS + WS_BAR), xb_x, xbst, (wave == 0) && (ln_ == 0)); } } while (0)
#endif
    const int gw = bx * 8 + wave, NGW = G * 8;
    const int gt = bx * 512 + tid, NGT = G * 512;

    if (IN(0)) {
        LAS float* scr = (LAS float*)(ldsl + wave * 16384);
        constexpr int I_IN = 32 * 48  , I_FOLD = 4 * 32 * 16, I_OUT = 32 * 64;
        constexpr int NITEMS = I_IN + I_FOLD + I_OUT;
        const float* w_in = KA_IN(3); const float* w_out = KA_IN(8); const float* w_pool = KA_IN(6); unsigned char* wsb = KA_WS;
        for (int rp = 0; rp < NREP(0); ++rp) {
        for (int half = 0; half < 2; ++half) {
            const bool do_rows = (half == 0) == ((wave & 1) != 0);
            if (do_rows) { rms_rows_to_bf16(KA_IN(0), KA_IN(1), KA_IN(2), XN, gw, NGW, lane); continue; }
            for (int it = gw; it < NITEMS; it += NGW) {
                int r = it;
                if (r < I_FOLD) { fold_pool_item(w_in, w_pool, (bf16r*)(wsb + WS_WIN), scr, r, lane); continue; } r -= I_FOLD;
                if (r < I_IN) { const int kb = r / 48, nb = r % 48; transpose_item<0>(w_in, 2048, N_IN, (bf16r*)(wsb + WS_WIN), 0, scr, kb * 80 + nb, lane); continue; } r -= I_IN;
                transpose_item<0>(w_out, 2048, 2048, (bf16r*)(wsb + WS_WOUT), 0, scr, r, lane);
            }
        }
        }
    }
    SEAM(0);
#ifdef PROBE_SYNC
    for (int i_ = 0; i_ < PROBE_SYNC; ++i_) grid_sync_fn();
#endif
    if (IN(1)) {
        pg8::Gemm g{XN, Win_t, M_ALL, N_IN, 2048}; pg8::StaticOrder S; S.init(M_ALL, N_IN, G, bx); S.reps = NREP(1);
        pg8::EpiBf16 E{Z, N_IN, 0, 0, nullptr};
        pg8::gemm_phase<pg8::EpiBf16, pg8::StaticOrder, true, true>(ldsl, g, S, E, wave);
        {
            const int remu = (192 * 10) % G, nidle = remu ? G - remu : G, rank = remu ? bx - remu : bx;
            if (rank >= 0) {
                __syncthreads();
                LAS float* scr = (LAS float*)(ldsl + wave * 16384);
                constexpr int I_UP = 32 * 352, I_DOWN = 88 * 64;
                const float* w_up = KA_IN(10); const float* w_down = KA_IN(13); const float* g_ffn = KA_IN(9); unsigned char* wsb = KA_WS;
                for (int it = rank * 8 + wave; it < I_UP + I_DOWN; it += nidle * 8) {
                    if (it < I_UP) transpose_item<1>(w_up, 2048, N_UP, (bf16r*)(wsb + WS_WUP), 0, scr, it, lane, g_ffn);
                    else transpose_item<0>(w_down, D_FF, 2048, (bf16r*)(wsb + WS_WDOWN), 0, scr, it - I_UP, lane);
                }
            }
        }
    }
    SEAM(1);
    if (IN(2)) {
        bf16r* zb = Z; bf16r* amb = AM; const float* gk = KA_IN(5); const float* psc = KA_IN(7);
        const int sub = gt & 7, a = sub >> 2, ch = sub & 3;
        float invf[8];
#pragma unroll
        for (int i = 0; i < 8; ++i) invf[i] = __builtin_amdgcn_exp2f(-(float)(8 * ch + i) * 0.41524101186092029f) * 0.15915494309189535f;
        for (int item = gt >> 3; item < M_ALL * 2; item += NGT >> 3) {
            const int row = item >> 1, hh = 8 + (item & 1);
            const int t = row < M_P ? (row & (L_P - 1)) : ((row - M_P) & (L_S - 1));
            const float pos = (float)(a == 0 ? (t >> 6) : (t & 63));
            bf16r* p = zb + (size_t)row * N_IN + (hh < 8 ? hh * 128 : 1024 + (hh - 8) * 128) + 64 * a + 8 * ch;
            const float* gn = gk + 64 * a + 8 * ch;
            const u32x4g A = *(const u32x4g*)p, B = *(const u32x4g*)(p + 32);
            float x1[8] = {bf_lo(A.x), bf_hi(A.x), bf_lo(A.y), bf_hi(A.y), bf_lo(A.z), bf_hi(A.z), bf_lo(A.w), bf_hi(A.w)};
            float x2[8] = {bf_lo(B.x), bf_hi(B.x), bf_lo(B.y), bf_hi(B.y), bf_lo(B.z), bf_hi(B.z), bf_lo(B.w), bf_hi(B.w)};
            float ss = 0.f;
#pragma unroll
            for (int i = 0; i < 8; ++i) ss += x1[i] * x1[i] + x2[i] * x2[i];
            ss += __shfl_xor(ss, 1); ss += __shfl_xor(ss, 2); ss += __shfl_xor(ss, 4);
            const float rstd = 1.0f / sqrtf(ss * (1.f / 128.f) + RMS_EPS);
            const f32x4g g1a = *(const f32x4g*)gn, g1b = *(const f32x4g*)(gn + 4), g2a = *(const f32x4g*)(gn + 32), g2b = *(const f32x4g*)(gn + 36);
            const float g1[8] = {g1a.x, g1a.y, g1a.z, g1a.w, g1b.x, g1b.y, g1b.z, g1b.w}, g2[8] = {g2a.x, g2a.y, g2a.z, g2a.w, g2b.x, g2b.y, g2b.z, g2b.w};
            float o1[8], o2[8];
#pragma unroll
            for (int i = 0; i < 8; ++i) { const float y1 = x1[i] * rstd * g1[i], y2 = x2[i] * rstd * g2[i]; const float rev = pos * invf[i];
                const float cs = __builtin_amdgcn_cosf(rev), sn = __builtin_amdgcn_sinf(rev); o1[i] = y1 * cs - y2 * sn; o2[i] = y2 * cs + y1 * sn; }
            u32x4g OA, OB; OA.x = pg8::cvt_pk_bf16(o1[0], o1[1]); OA.y = pg8::cvt_pk_bf16(o1[2], o1[3]); OA.z = pg8::cvt_pk_bf16(o1[4], o1[5]); OA.w = pg8::cvt_pk_bf16(o1[6], o1[7]);
            OB.x = pg8::cvt_pk_bf16(o2[0], o2[1]); OB.y = pg8::cvt_pk_bf16(o2[2], o2[3]); OB.z = pg8::cvt_pk_bf16(o2[4], o2[5]); OB.w = pg8::cvt_pk_bf16(o2[6], o2[7]);
            *(u32x4g*)p = OA; *(u32x4g*)(p + 32) = OB;
        }
        for (int rp = 0; rp < NREP(2); ++rp)
        for (int item = gt; item < 4 * (M_ALL / 8) * 32; item += NGT) {
            const int g = item / ((M_ALL / 8) * 32), rem = item - g * ((M_ALL / 8) * 32), rb = rem >> 5, c8 = (rem & 31) * 8, row0 = rb * 8;
            const int L = row0 < M_P ? L_P : L_S, t0 = row0 < M_P ? (row0 & (L_P - 1)) : ((row0 - M_P) & (L_S - 1));
            const bf16r* vcol = zb + (size_t)(row0 - t0) * N_IN + 1536 + g * 256 + c8; bf16r* ocol = amb + (size_t)row0 * 2048 + 1024 + g * 256 + c8; const float* sc8 = psc + g * 256 + c8;
            if (g == 0) pool_item<1>(vcol, t0, L, sc8, ocol); else if (g == 1) pool_item<2>(vcol, t0, L, sc8, ocol); else if (g == 2) pool_item<4>(vcol, t0, L, sc8, ocol); else pool_item<8>(vcol, t0, L, sc8, ocol);
        }
    }
    SEAM(2);
    if (IN(3)) {
        for (int Lu_ = bx; Lu_ < 1536 * NREP(3); Lu_ += G) { const int Lu = Lu_ % 1536;
            const int r = Lu >> 8, cc = Lu & 255, x = cc & 7, slot = cc >> 3, b = x >> 1, kvh = x & 1;
            int head, qb, seq, row0;
            if (r < 4) { head = kvh * 4 + r; qb = slot; seq = L_S; row0 = M_P + b * L_S; }
            else { head = kvh * 4 + (r - 4) * 2 + (slot >> 4); qb = slot & 15; seq = L_P; row0 = b * L_P; }
            const bf16r* zb = Z;
            const att::bf16* Qb = (const att::bf16*)(zb + (size_t)(row0 + qb * 256) * N_IN + head * 128);
            const att::bf16* Kh = (const att::bf16*)(zb + (size_t)row0 * N_IN + 1024 + kvh * 128);
            const att::bf16* Vh = (const att::bf16*)(zb + (size_t)row0 * N_IN + 1280 + kvh * 128);
            unsigned* Ob = (unsigned*)(AM + (size_t)(row0 + qb * 256) * 2048 + head * 128);
            att::attn_dense_body<att::bf16>(Qb, Kh, Vh, Ob, seq, (char*)lds, KA_IN(4), qb * 256, KA_IN(5), wave);
        }
    }
    SEAM(3);
    if (IN(4)) {
        pg8::Gemm g{AM, Wout_t, M_ALL, 2048, 2048}; pg8::StaticOrder S; S.init(M_ALL, 2048, G, bx); S.reps = NREP(4);
        pg8::EpiResNorm E{KA_IN(0), KA_IN(1), XN, SSQ, (LAS float*)(ldsl + XCH_OFF)};
        pg8::gemm_phase<pg8::EpiResNorm, pg8::StaticOrder, true, true>(ldsl, g, S, E, wave);
    }
#ifdef PROBE_X4
    if (IN(4)) { __syncthreads();
        pg8::Gemm g{AM, Wout_t, M_ALL, 2048, 2048}; pg8::StaticOrder S; S.init(M_ALL, 2048, G, bx);
        pg8::EpiBf16 E{ACT, 2048, 0, 0, nullptr};
        pg8::gemm_phase<pg8::EpiBf16, pg8::StaticOrder, true, true>(ldsl, g, S, E, wave);
    }
#endif
    SEAM(4);
    if (IN(5)) {
        const float* ssq = SSQ; float* rstd = RSTD;
        for (int row = gt; row < M_ALL; row += NGT) { float q = 0.f;
#pragma unroll
            for (int p = 0; p < 8; ++p) q += ssq[(size_t)p * M_ALL + row];
            rstd[row] = 1.0f / sqrtf(q * (1.f / 2048.f) + RMS_EPS); }
    }
    SEAM(5);
    if (IN(6)) {
        pg8::Gemm g{XN, Wup_t, M_ALL, N_UP, 2048}; pg8::StaticOrder S; S.init(M_ALL, N_UP, G, bx); S.reps = NREP(6);
        pg8::EpiConvGlu E{ACT, KA_IN(11), KA_IN(12), HS, HV, HG, (LAS float*)(ldsl + XCH_OFF), RSTD};
        pg8::gemm_phase<pg8::EpiConvGlu, pg8::StaticOrder, true, true>(ldsl, g, S, E, wave);
    }
    SEAM(6);
    if (IN(7)) {
        const float* wc = KA_IN(11); const float* hs = HS; const float* hv = HV; const float* hg = HG; bf16r* actb = ACT;
        for (int item = gt; item < N_TILES_M * 2 * (D_FF / 4); item += NGT) {
            const int c4 = (item % (D_FF / 4)) * 4, pe = item / (D_FF / 4), pm = pe >> 1, e = pe & 1;
            const int tps = pm < 64 ? 16 : 32, ti = pm < 64 ? (pm & 15) : ((pm - 64) & 31);
            if (e == 0 ? (ti == 0) : (ti == tps - 1)) continue;
            const size_t ho = (size_t)pe * D_FF + c4;
            const f32x4g s0 = *(const f32x4g*)(hs + ho), v = *(const f32x4g*)(hv + ho);
            const f32x4g gn = e == 0 ? *(const f32x4g*)(hg + ((size_t)(pm - 1) * 2 + 1) * D_FF + c4) : *(const f32x4g*)(hg + ((size_t)(pm + 1) * 2 + 0) * D_FF + c4);
            const f32x4g w = *(const f32x4g*)(wc + (e == 0 ? 0 : 2 * D_FF) + c4);
            const f32x4g s = s0 + w * gn;
            u32x2g o; o.x = pg8::cvt_pk_bf16(pg8::silu_f(s.x) * v.x, pg8::silu_f(s.y) * v.y); o.y = pg8::cvt_pk_bf16(pg8::silu_f(s.z) * v.z, pg8::silu_f(s.w) * v.w);
            *(u32x2g*)(actb + ((size_t)pm * 256 + (e ? 255 : 0)) * D_FF + c4) = o;
        }
    }
    SEAM(7);
    if (IN(8)) {
        pg8::Gemm g{ACT, Wdown_t, M_ALL, 2048, D_FF}; pg8::StaticOrder S; S.init(M_ALL, 2048, G, bx); S.reps = NREP(8);
        pg8::EpiResOut E{XN, KA_OUT};
        pg8::gemm_phase<pg8::EpiResOut, pg8::StaticOrder, true, true>(ldsl, g, S, E, wave);
    }
#undef IN
#undef SEAM
}

extern "C" void kernel_launch(void* const* d_in, const int* in_sizes, int n_in, void* d_out, int out_size, void* d_ws, size_t ws_size, hipStream_t stream) {
    static int grid = 0;
    if (grid == 0) {
        if (n_in != 14 || in_sizes[0] != M_P * 2048 || in_sizes[1] != M_S * 2048 || out_size != M_ALL * 2048 || ws_size < WS_END) {
            fprintf(stderr, "kernel_launch: shape mismatch (n_in %d, in0 %d, in1 %d, out %d, ws %zu; need ws >= %zu)\n", n_in, n_in > 0 ? in_sizes[0] : -1, n_in > 1 ? in_sizes[1] : -1, out_size, ws_size, (size_t)WS_END);
            grid = -1; return; }
        int dev = 0, cus = 0, per_cu = 0;
        if (hipGetDevice(&dev) != hipSuccess || hipDeviceGetAttribute(&cus, hipDeviceAttributeMultiprocessorCount, dev) != hipSuccess) { grid = -1; return; }
        if (hipFuncSetAttribute((const void*)fwd_megakernel, hipFuncAttributeMaxDynamicSharedMemorySize, LDS_BYTES) != hipSuccess) { fprintf(stderr, "kernel_launch: hipFuncSetAttribute failed\n"); grid = -1; return; }
        if (hipOccupancyMaxActiveBlocksPerMultiprocessor(&per_cu, (const void*)fwd_megakernel, 512, LDS_BYTES) != hipSuccess || per_cu < 1) { fprintf(stderr, "kernel_launch: occupancy query gave %d\n", per_cu); per_cu = 1; }
        (void)hipGetLastError();
        grid = cus * 1;
        if (grid <= 0) { grid = -1; return; }
    }
    if (grid < 0) return;
    Args a{};
    for (int i = 0; i < 14; ++i) a.in[i] = (const float*)d_in[i];
    a.out = (float*)d_out; a.ws = (unsigned char*)d_ws;
#if MK_PER_PHASE
    for (int ph = 0; ph < N_PHASES; ++ph) { a.ph_lo = ph; a.ph_hi = ph + 1; hipLaunchKernelGGL(fwd_megakernel, dim3(grid), dim3(512), LDS_BYTES, stream, a); }
#else
    a.ph_lo = 0; a.ph_hi = N_PHASES;
    void* kargs[] = {&a};
    if (hipMemsetAsync((unsigned char*)d_ws + WS_BAR, 0, 16384, stream) != hipSuccess) { fprintf(stderr, "kernel_launch: hipMemsetAsync of the barrier words failed\n"); return; }
    const hipError_t e = hipLaunchCooperativeKernel((const void*)fwd_megakernel, dim3(grid), dim3(512), kargs, LDS_BYTES, stream);
    if (e != hipSuccess) fprintf(stderr, "kernel_launch: cooperative launch failed: %s (grid %d)\n", hipGetErrorString(e), grid);
#endif
}
```

```cpp
#include <hip/hip_runtime.h>
#include <hip/hip_bf16.h>
#include <hip/hip_cooperative_groups.h>
#include <cstdio>
#include <cstdint>
#include <cmath>
namespace cg = cooperative_groups;

constexpr int DMODEL = 2048, M_P = 16384, M_S = 32768, M_ALL = 49152, L_P = 4096, L_S = 8192;
constexpr int N_IN = 2560, D_FF = 5632, N_UP = 11264, N_TILES_M = M_ALL / 256;
constexpr float RMS_EPS = 1e-6f;
namespace pg8 {
#define PG8_LAS __attribute__((address_space(3)))
typedef unsigned short bf16_t;
typedef short bf16x8 __attribute__((ext_vector_type(8)));
typedef float f32x4 __attribute__((ext_vector_type(4)));
typedef unsigned u32x4 __attribute__((ext_vector_type(4)));
constexpr int BM = 256, BK = 64, HALF = 128, HTB = HALF * BK * 2  , STAGE_BYTES = 8 * HTB, NXCD = 8, WGM = 8;

__host__ __device__ __forceinline__ int lds_byte(int r, int c) { const int st = (r >> 4) * 2 + (c >> 5), rr = r & 15, cc = c & 31, ob = rr * 64 + cc * 2; return st * 1024 + (ob ^ (((ob >> 9) & 1) << 5)); }
__host__ __device__ __forceinline__ void stage_rc(int b, int& R, int& C) { const int st = b / 1024, sb = b % 1024, swz = sb ^ (((sb >> 9) & 1) << 5); R = (st >> 1) * 16 + swz / 64; C = (st & 1) * 32 + (swz % 64) / 2; }
__host__ __device__ __forceinline__ int perm32(int rho) { const int n = rho >> 4, i = rho & 15; return 8 * (i >> 2) + 4 * n + (i & 3); }

struct Unit { int pm, pn; };
struct Gemm { const bf16_t* A; const bf16_t* Bt; int M, N, K; };

struct StaticOrder {
    int nM, nN, nwg, G, c, reps, wgm;
    __host__ __device__ void init(int M, int N, int G_, int c_) { nM = M / BM; nN = N / BM; nwg = nM * nN; G = G_; c = c_; reps = 1; wgm = WGM; }
    __host__ __device__ bool next(int i, Unit& u) const {
        const long L = (long)i * G + c; if (L >= (long)nwg * reps) return false;
        int wgid = (int)(L % nwg); { const int q = nwg / NXCD, r = nwg % NXCD, xcd = wgid % NXCD, off = wgid / NXCD; wgid = (xcd < r ? xcd * (q + 1) : r * (q + 1) + (xcd - r) * q) + off; }
        const int nig = wgm * nN, gid = wgid / nig, fm = gid * wgm, gsz = (nM - fm) < wgm ? (nM - fm) : wgm;
        u.pm = fm + ((wgid % nig) % gsz); u.pn = (wgid % nig) / gsz; return true;
    }
    __device__ __forceinline__ void a_ready(const Unit&) const {}
    __device__ __forceinline__ void done(const Unit&) const {}
};
__device__ __forceinline__ unsigned cvt_pk_bf16(float lo, float hi) { unsigned r; asm volatile("v_cvt_pk_bf16_f32 %0, %1, %2" : "=v"(r) : "v"(lo), "v"(hi)); return r; }
typedef float f32x2 __attribute__((ext_vector_type(2)));
constexpr int D_FF_C = 5632;
struct EpiBf16 {
    static constexpr bool PERM = true, AFTER_DRAIN = false;
    bf16_t* O; int ldc; int pm_mod; int col_off; const float* cscale;
    __device__ __forceinline__ void operator()(const f32x4 (&acc)[2][2][4][2], const Unit& u, int wr, int wc, int fr, int fq) const {
        const int pm = pm_mod ? (u.pm % pm_mod) : u.pm;
        const int row0 = pm * BM + wr * 64 + fr; const int lc = u.pn * BM + wc * 32 + 8 * fq;
        f32x4 sv[2][2];
#pragma unroll
        for (int bj = 0; bj < 2; ++bj)
#pragma unroll
            for (int n = 0; n < 2; ++n) sv[bj][n] = cscale ? *(const f32x4*)(cscale + lc + bj * HALF + 4 * n) : (f32x4){1.f, 1.f, 1.f, 1.f};
#pragma unroll
        for (int ai = 0; ai < 2; ++ai)
#pragma unroll
            for (int m = 0; m < 4; ++m) { bf16_t* rowp = O + (size_t)(row0 + ai * HALF + m * 16) * ldc + col_off + lc;
#pragma unroll
                for (int bj = 0; bj < 2; ++bj) { const f32x4 v0 = acc[ai][bj][m][0] * sv[bj][0], v1 = acc[ai][bj][m][1] * sv[bj][1];
                    u32x4 w; w.x = cvt_pk_bf16(v0[0], v0[1]); w.y = cvt_pk_bf16(v0[2], v0[3]); w.z = cvt_pk_bf16(v1[0], v1[1]); w.w = cvt_pk_bf16(v1[2], v1[3]);
                    *(u32x4*)(rowp + bj * HALF) = w; } }
    }
};
struct EpiResOut {
    static constexpr bool PERM = false, AFTER_DRAIN = false;
    const bf16_t* xb; float* out;
    __device__ __forceinline__ void operator()(const f32x4 (&acc)[2][2][4][2], const Unit& u, int wr, int wc, int fr, int fq) const {
        typedef unsigned u32x2 __attribute__((ext_vector_type(2)));
        const int col0 = u.pn * BM + wc * 32 + 4 * fq;
        u32x2 xv[2][4][2][2];
#pragma unroll
        for (int ai = 0; ai < 2; ++ai)
#pragma unroll
            for (int m = 0; m < 4; ++m) { const size_t r = (size_t)u.pm * BM + ai * HALF + wr * 64 + m * 16 + fr;
#pragma unroll
                for (int bj = 0; bj < 2; ++bj)
#pragma unroll
                    for (int n = 0; n < 2; ++n) xv[ai][m][bj][n] = *(const u32x2*)(xb + r * 2048 + col0 + bj * HALF + n * 16); }
#pragma unroll
        for (int ai = 0; ai < 2; ++ai)
#pragma unroll
            for (int m = 0; m < 4; ++m) { const size_t r = (size_t)u.pm * BM + ai * HALF + wr * 64 + m * 16 + fr; float* orow = out + r * 2048;
#pragma unroll
                for (int bj = 0; bj < 2; ++bj)
#pragma unroll
                    for (int n = 0; n < 2; ++n) { const u32x2 w = xv[ai][m][bj][n];
                        const f32x4 b = (f32x4){__uint_as_float(w.x << 16), __uint_as_float(w.x & 0xffff0000u), __uint_as_float(w.y << 16), __uint_as_float(w.y & 0xffff0000u)};
                        *(f32x4*)(orow + col0 + bj * HALF + n * 16) = b + acc[ai][bj][m][n]; } }
    }
};
struct EpiResNorm {
    static constexpr bool PERM = false, AFTER_DRAIN = false;
    const float* xp; const float* xs; bf16_t* xn; float* ss; PG8_LAS float* P;
    __device__ __forceinline__ void operator()(const f32x4 (&acc)[2][2][4][2], const Unit& u, int wr, int wc, int fr, int fq) const {
        typedef unsigned u32x2 __attribute__((ext_vector_type(2)));
        const int col0 = u.pn * BM + wc * 32 + 4 * fq;
#pragma unroll
        for (int ai = 0; ai < 2; ++ai) {
            f32x4 xv[4][2][2];
#pragma unroll
            for (int m = 0; m < 4; ++m) { const int r = u.pm * BM + ai * HALF + wr * 64 + m * 16 + fr;
                const float* xr = r < 16384 ? xp + (size_t)r * 2048 : xs + (size_t)(r - 16384) * 2048;
#pragma unroll
                for (int bj = 0; bj < 2; ++bj)
#pragma unroll
                    for (int n = 0; n < 2; ++n) xv[m][bj][n] = *(const f32x4*)(xr + col0 + bj * HALF + n * 16); }
            asm volatile("" ::: "memory");
#pragma unroll
            for (int m = 0; m < 4; ++m) { const int rl = ai * HALF + wr * 64 + m * 16 + fr, r = u.pm * BM + rl;
                bf16_t* nrow = xn + (size_t)r * 2048; float sq = 0.f;
#pragma unroll
                for (int bj = 0; bj < 2; ++bj)
#pragma unroll
                    for (int n = 0; n < 2; ++n) { const int c = col0 + bj * HALF + n * 16; const f32x4 v = xv[m][bj][n] + acc[ai][bj][m][n];
                        sq += (v[0] * v[0] + v[1] * v[1]) + (v[2] * v[2] + v[3] * v[3]);
                        u32x2 w; w.x = cvt_pk_bf16(v[0], v[1]); w.y = cvt_pk_bf16(v[2], v[3]); *(u32x2*)(nrow + c) = w; }
                sq += __shfl_xor(sq, 16); sq += __shfl_xor(sq, 32);
                if (fq == 0) P[rl * 4 + wc] = sq; }
            asm volatile("" ::: "memory");
        }
        asm volatile("s_waitcnt lgkmcnt(0)" ::: "memory"); __builtin_amdgcn_s_barrier(); asm volatile("" ::: "memory");
        const int t = (wr * 4 + wc) * 64 + fq * 16 + fr;
        if (t < 256) { const f32x4 p = *(const PG8_LAS f32x4*)(P + t * 4); ss[(size_t)u.pn * 49152 + u.pm * BM + t] = (p[0] + p[1]) + (p[2] + p[3]); }
    }
};
__device__ __forceinline__ float dpp_ror1(float v) { return __builtin_bit_cast(float, __builtin_amdgcn_update_dpp(0, __builtin_bit_cast(int, v), 0x121, 0xf, 0xf, false)); }
__device__ __forceinline__ float dpp_ror15(float v) { return __builtin_bit_cast(float, __builtin_amdgcn_update_dpp(0, __builtin_bit_cast(int, v), 0x12F, 0xf, 0xf, false)); }
__device__ __forceinline__ f32x4 ror1_4(f32x4 v) { return (f32x4){dpp_ror1(v[0]), dpp_ror1(v[1]), dpp_ror1(v[2]), dpp_ror1(v[3])}; }
__device__ __forceinline__ f32x4 ror15_4(f32x4 v) { return (f32x4){dpp_ror15(v[0]), dpp_ror15(v[1]), dpp_ror15(v[2]), dpp_ror15(v[3])}; }
__device__ __forceinline__ float silu_f(float s) { return s * __builtin_amdgcn_rcpf(1.0f + __builtin_amdgcn_exp2f(-1.4426950408889634f * s)); }
struct EpiConvGlu {
    static constexpr bool PERM = true, AFTER_DRAIN = false;
    bf16_t* act; const float* wconv; const float* bconv; float* hS; float* hV; float* hG; PG8_LAS float* xch; const float* rstd;
    __device__ __forceinline__ void operator()(f32x4 (&acc)[2][2][4][2], const Unit& u, int wr, int wc, int fr, int fq) const {
        const int cl = wc * 32 + 8 * fq, gc = u.pn * HALF + cl;
        f32x4 w0[2], w1[2], w2[2], bb[2];
#pragma unroll
        for (int n = 0; n < 2; ++n) { w0[n] = *(const f32x4*)(wconv + gc + 4 * n); w1[n] = *(const f32x4*)(wconv + D_FF_C + gc + 4 * n);
            w2[n] = *(const f32x4*)(wconv + 2 * D_FF_C + gc + 4 * n); bb[n] = *(const f32x4*)(bconv + gc + 4 * n); }
        float rs[2][4];
#pragma unroll
        for (int ai = 0; ai < 2; ++ai)
#pragma unroll
            for (int m = 0; m < 4; ++m) rs[ai][m] = rstd[u.pm * BM + ai * HALF + wr * 64 + m * 16 + fr];
#pragma unroll
        for (int ai = 0; ai < 2; ++ai)
#pragma unroll
            for (int m = 0; m < 4; ++m)
#pragma unroll
                for (int bj = 0; bj < 2; ++bj)
#pragma unroll
                    for (int n = 0; n < 2; ++n) acc[ai][bj][m][n] = acc[ai][bj][m][n] * rs[ai][m];
#pragma unroll
        for (int ai = 0; ai < 2; ++ai) { const int blk = 2 * ai + wr;
            if (fr == 0) { *(PG8_LAS f32x4*)(xch + (blk * 2 + 0) * HALF + cl) = acc[ai][0][0][0]; *(PG8_LAS f32x4*)(xch + (blk * 2 + 0) * HALF + cl + 4) = acc[ai][0][0][1]; }
            if (fr == 15) { *(PG8_LAS f32x4*)(xch + (blk * 2 + 1) * HALF + cl) = acc[ai][0][3][0]; *(PG8_LAS f32x4*)(xch + (blk * 2 + 1) * HALF + cl + 4) = acc[ai][0][3][1]; } }
        asm volatile("s_waitcnt lgkmcnt(0)" ::: "memory"); __builtin_amdgcn_s_barrier(); asm volatile("" ::: "memory");
#pragma unroll
        for (int ai = 0; ai < 2; ++ai) { const int blk = 2 * ai + wr;
            f32x4 top[2], bot[2];
#pragma unroll
            for (int n = 0; n < 2; ++n) {
                top[n] = blk > 0 ? *(const PG8_LAS f32x4*)(xch + ((blk - 1) * 2 + 1) * HALF + cl + 4 * n) : (f32x4){0.f, 0.f, 0.f, 0.f};
                bot[n] = blk < 3 ? *(const PG8_LAS f32x4*)(xch + ((blk + 1) * 2 + 0) * HALF + cl + 4 * n) : (f32x4){0.f, 0.f, 0.f, 0.f}; }
#pragma unroll
            for (int m = 0; m < 4; ++m) { const int rl = ai * HALF + wr * 64 + m * 16 + fr; const size_t r = (size_t)u.pm * BM + rl;
                u32x4 w;
#pragma unroll
                for (int n = 0; n < 2; ++n) {
                    const f32x4 g = acc[ai][0][m][n];
                    f32x4 up = ror1_4(g), dn = ror15_4(g);
                    if (m > 0) { const f32x4 pu = ror1_4(acc[ai][0][m > 0 ? m - 1 : 0][n]); if (fr == 0) up = pu; } else { if (fr == 0) up = top[n]; }
                    if (m < 3) { const f32x4 pd = ror15_4(acc[ai][0][m < 3 ? m + 1 : 3][n]); if (fr == 15) dn = pd; } else { if (fr == 15) dn = bot[n]; }
                    const f32x4 s = w0[n] * up + w1[n] * g + w2[n] * dn + bb[n];
                    const f32x4 v = acc[ai][1][m][n];
                    const f32x4 a = (f32x4){silu_f(s[0]) * v[0], silu_f(s[1]) * v[1], silu_f(s[2]) * v[2], silu_f(s[3]) * v[3]};
                    if (n == 0) { w.x = cvt_pk_bf16(a[0], a[1]); w.y = cvt_pk_bf16(a[2], a[3]); } else { w.z = cvt_pk_bf16(a[0], a[1]); w.w = cvt_pk_bf16(a[2], a[3]); }
                    if (rl == 0 || rl == 255) { const size_t ho = ((size_t)u.pm * 2 + (rl ? 1 : 0)) * D_FF_C + gc + 4 * n;
                        *(f32x4*)(hS + ho) = s; *(f32x4*)(hV + ho) = v; *(f32x4*)(hG + ho) = g; }
                }
                *(u32x4*)(act + r * D_FF_C + gc) = w; } }
    }
};
template <class Epi, class Sched, bool ALIGN_EPI = false, bool SP2 = false>
__device__ __forceinline__ void gemm_phase(PG8_LAS unsigned char* lds, const Gemm g, const Sched& S, const Epi& E, const int mk_wave) {
    const int lane = (int)__builtin_amdgcn_mbcnt_hi(~0u, __builtin_amdgcn_mbcnt_lo(~0u, 0u)), wid = mk_wave, tid = wid * 64 + lane, wr = wid >> 2, wc = wid & 3, fr = lane & 15, fq = lane >> 4;
    const int K = g.K, nt = K / BK;
    unsigned voffA[2], voffB[2];
#pragma unroll
    for (int i = 0; i < 2; ++i) { int R, C; stage_rc(tid * 16 + i * 8192, R, C); const int Rb = Epi::PERM ? ((R & ~31) + perm32(R & 31)) : R;
        voffA[i] = (unsigned)(R * K + C) * 2u; voffB[i] = (unsigned)(Rb * K + C) * 2u; }
    const size_t kstep = (size_t)(BK * 2);
    const size_t hstep = (size_t)HALF * K * 2;
    const size_t tstep = 2 * hstep;
    const unsigned ldsw = (unsigned)wid * 1024u;
    const int aoff = lds_byte(wr * 64 + fr, fq * 8), boff = lds_byte(wc * 32 + fr, fq * 8);
#define PG8_SA(b, h) (((b) * 2 + (h)) * HTB)
#define PG8_SB(b, h) ((4 + (b) * 2 + (h)) * HTB)
#define PG8_STAGE(bufoff, gbase, voff) do { _Pragma("unroll") for (int _i = 0; _i < 2; ++_i) \
        __builtin_amdgcn_global_load_lds((const unsigned*)((const char*)(gbase) + (voff)[_i]), (PG8_LAS unsigned*)(lds + (bufoff) + ldsw + _i * 8192), 16, 0, 0); } while (0)
#define PG8_LDA(dst, b, h) do { _Pragma("unroll") for (int m = 0; m < 4; ++m) _Pragma("unroll") for (int k = 0; k < 2; ++k) dst[m][k] = *(const PG8_LAS bf16x8*)(lds + PG8_SA(b, h) + aoff + m * 2048 + k * 1024); } while (0)
#define PG8_LDB(dst, b, h) do { _Pragma("unroll") for (int n = 0; n < 2; ++n) _Pragma("unroll") for (int k = 0; k < 2; ++k) dst[n][k] = *(const PG8_LAS bf16x8*)(lds + PG8_SB(b, h) + boff + n * 2048 + k * 1024); } while (0)
#define PG8_MMA(ai, bj, At, Bt) do { __builtin_amdgcn_s_setprio(1); _Pragma("unroll") for (int m = 0; m < 4; ++m) _Pragma("unroll") for (int n = 0; n < 2; ++n) _Pragma("unroll") for (int k = 0; k < 2; ++k) \
        acc[ai][bj][m][n] = __builtin_amdgcn_mfma_f32_16x16x32_bf16(Bt[n][k], At[m][k], acc[ai][bj][m][n], 0, 0, 0); __builtin_amdgcn_s_setprio(0); } while (0)
#define PG8_WAIT_V(n) asm volatile("s_waitcnt vmcnt(" #n ")" ::: "memory")
#define PG8_WAIT_L(n) asm volatile("s_waitcnt lgkmcnt(" #n ")" ::: "memory")
#define PG8_BAR __builtin_amdgcn_s_barrier()
#define PG8_SCHED __builtin_amdgcn_sched_barrier(0)
    Unit cur, nxt; int ui = 0;
    if (!S.next(0, cur)) return;
    f32x4 acc[2][2][4][2];
#pragma unroll
    for (int a = 0; a < 2; ++a)
#pragma unroll
        for (int b = 0; b < 2; ++b)
#pragma unroll
            for (int m = 0; m < 4; ++m)
#pragma unroll
                for (int n = 0; n < 2; ++n) acc[a][b][m][n] = (f32x4){0.f, 0.f, 0.f, 0.f};
    bf16x8 At[4][2], B0[2][2], B1[2][2];
    const char* cA = (const char*)g.A + (size_t)cur.pm * tstep; const char* cB = (const char*)g.Bt + (size_t)cur.pn * tstep;
    S.a_ready(cur);
    if constexpr (SP2) {
        PG8_STAGE(PG8_SB(0, 0), cB, voffB); PG8_STAGE(PG8_SB(0, 1), cB + hstep, voffB); PG8_STAGE(PG8_SA(0, 0), cA, voffA); PG8_STAGE(PG8_SA(0, 1), cA + hstep, voffA);
        if (wr == 1) PG8_BAR;
        PG8_WAIT_V(2); PG8_BAR;
        PG8_STAGE(PG8_SB(1, 0), cB + kstep, voffB); PG8_STAGE(PG8_SA(1, 0), cA + kstep, voffA); PG8_STAGE(PG8_SB(1, 1), cB + hstep + kstep, voffB);
        PG8_WAIT_V(6); PG8_BAR;
    } else {
        PG8_STAGE(PG8_SB(0, 0), cB, voffB); PG8_STAGE(PG8_SA(0, 0), cA, voffA); PG8_STAGE(PG8_SB(0, 1), cB + hstep, voffB); PG8_STAGE(PG8_SA(0, 1), cA + hstep, voffA);
        if (wr == 1) PG8_BAR;
        PG8_WAIT_V(4); PG8_BAR;
        PG8_STAGE(PG8_SB(1, 0), cB + kstep, voffB); PG8_STAGE(PG8_SA(1, 0), cA + kstep, voffA); PG8_STAGE(PG8_SB(1, 1), cB + hstep + kstep, voffB);
        PG8_WAIT_V(6); PG8_BAR;
    }
    for (;;) {
        const bool has_next = S.next(ui + 1, nxt);
        const char* nA = has_next ? (const char*)g.A + (size_t)nxt.pm * tstep : cA; const char* nB = has_next ? (const char*)g.Bt + (size_t)nxt.pn * tstep : cB;
        for (int t = 0; t < nt; t += 2) {
            const bool last = (t == nt - 2);
            const char* a1 = cA + (size_t)(t + 1) * kstep;
            const char* a2 = last ? nA : cA + (size_t)(t + 2) * kstep; const char* b2 = last ? nB : cB + (size_t)(t + 2) * kstep;
            const char* a3 = a2 + kstep; const char* b3 = b2 + kstep;
            if (last && has_next) S.a_ready(nxt);
            if constexpr (SP2) {
            PG8_LDB(B0, 0, 0); PG8_LDB(B1, 0, 1); PG8_SCHED; PG8_LDA(At, 0, 0); PG8_STAGE(PG8_SA(1, 1), a1 + hstep, voffA);
            PG8_WAIT_V(8); PG8_WAIT_L(0); PG8_BAR; PG8_MMA(0, 0, At, B0); PG8_MMA(0, 1, At, B1); PG8_BAR; PG8_SCHED;
            PG8_LDA(At, 0, 1); PG8_STAGE(PG8_SB(0, 0), b2, voffB); PG8_STAGE(PG8_SB(0, 1), b2 + hstep, voffB); PG8_STAGE(PG8_SA(0, 0), a2, voffA);
            PG8_WAIT_V(8); PG8_WAIT_L(0); PG8_BAR; PG8_MMA(1, 0, At, B0); PG8_MMA(1, 1, At, B1); PG8_BAR; PG8_SCHED;
            PG8_LDB(B0, 1, 0); PG8_LDB(B1, 1, 1); PG8_SCHED; PG8_LDA(At, 1, 0); PG8_STAGE(PG8_SA(0, 1), a2 + hstep, voffA);
            PG8_WAIT_V(8); PG8_WAIT_L(0); PG8_BAR; PG8_MMA(0, 0, At, B0); PG8_MMA(0, 1, At, B1); PG8_BAR; PG8_SCHED;
            PG8_LDA(At, 1, 1); PG8_STAGE(PG8_SB(1, 0), b3, voffB); PG8_STAGE(PG8_SB(1, 1), b3 + hstep, voffB); PG8_STAGE(PG8_SA(1, 0), a3, voffA);
            PG8_WAIT_V(8); PG8_WAIT_L(0); PG8_BAR; PG8_MMA(1, 0, At, B0); PG8_MMA(1, 1, At, B1); PG8_BAR; PG8_SCHED;
            } else {
            PG8_LDB(B0, 0, 0); PG8_SCHED; PG8_LDA(At, 0, 0); PG8_STAGE(PG8_SA(1, 1), a1 + hstep, voffA);
            PG8_WAIT_L(8); PG8_BAR; PG8_WAIT_L(0); PG8_MMA(0, 0, At, B0); PG8_BAR; PG8_SCHED;
            PG8_LDB(B1, 0, 1); PG8_STAGE(PG8_SB(0, 0), b2, voffB);
            PG8_BAR; PG8_WAIT_L(0); PG8_MMA(0, 1, At, B1); PG8_BAR;
            PG8_LDA(At, 0, 1); PG8_STAGE(PG8_SA(0, 0), a2, voffA);
            PG8_BAR; PG8_WAIT_L(0); PG8_MMA(1, 0, At, B0); PG8_BAR; PG8_SCHED;
            PG8_STAGE(PG8_SB(0, 1), b2 + hstep, voffB);
            PG8_WAIT_V(6); PG8_BAR; PG8_MMA(1, 1, At, B1); PG8_BAR;
            PG8_LDB(B0, 1, 0); PG8_SCHED; PG8_LDA(At, 1, 0); PG8_STAGE(PG8_SA(0, 1), a2 + hstep, voffA);
            PG8_WAIT_L(8); PG8_BAR; PG8_WAIT_L(0); PG8_MMA(0, 0, At, B0); PG8_BAR; PG8_SCHED;
            PG8_LDB(B1, 1, 1); PG8_STAGE(PG8_SB(1, 0), b3, voffB);
            PG8_BAR; PG8_WAIT_L(0); PG8_MMA(0, 1, At, B1); PG8_BAR;
            PG8_LDA(At, 1, 1); PG8_STAGE(PG8_SA(1, 0), a3, voffA);
            PG8_BAR; PG8_WAIT_L(0); PG8_MMA(1, 0, At, B0); PG8_BAR; PG8_SCHED;
            PG8_STAGE(PG8_SB(1, 1), b3 + hstep, voffB);
            PG8_WAIT_V(6); PG8_BAR; PG8_MMA(1, 1, At, B1); PG8_BAR;
            }
        }
        if constexpr (ALIGN_EPI) { if (wr == 0) PG8_BAR; }
        if constexpr (!Epi::AFTER_DRAIN) { E(acc, cur, wr, wc, fr, fq); S.done(cur); }
        if (!has_next) break;
#pragma unroll
        for (int a = 0; a < 2; ++a)
#pragma unroll
            for (int b = 0; b < 2; ++b)
#pragma unroll
                for (int m = 0; m < 4; ++m)
#pragma unroll
                    for (int n = 0; n < 2; ++n) acc[a][b][m][n] = (f32x4){0.f, 0.f, 0.f, 0.f};
        cur = nxt; cA = nA; cB = nB; ++ui;
        if constexpr (ALIGN_EPI) { if (wr == 1) PG8_BAR; }
    }
    PG8_WAIT_V(0);
    if constexpr (!ALIGN_EPI) { if (wr == 0) PG8_BAR; }
    PG8_BAR;
    if constexpr (Epi::AFTER_DRAIN) { E.fused(acc, cur, wr, wc, fr, fq, lds, wid, lane); S.done(cur); }
#undef PG8_SA
#undef PG8_SB
#undef PG8_STAGE
#undef PG8_LDA
#undef PG8_LDB
#undef PG8_MMA
#undef PG8_WAIT_V
#undef PG8_WAIT_L
#undef PG8_BAR
#undef PG8_SCHED
}
}
namespace att {
using bf16 = __hip_bfloat16;
constexpr int   D = 128, NW = 8, QBLK = 32, KVBLK = 64;
constexpr float SCALE = 0.088388347648318440f;
constexpr float THR = 8.f;
constexpr int SDEPTH = 2;
constexpr int LDQ = 2560, LDK = 2560, LDO = 2048;
constexpr size_t SHM_V = KVBLK * D * 2, SHM_K = KVBLK * D * 2, SHM_ATTN = 2 * SHM_V + 2 * SHM_K + NW * 64 * 4;
using bf16x8 = __attribute__((ext_vector_type(8))) short;
using s16x4  = __attribute__((ext_vector_type(4))) short;
using f32x16 = __attribute__((ext_vector_type(16))) float;
using f32x8  = __attribute__((ext_vector_type(8))) float;
using u32x4  = __attribute__((ext_vector_type(4))) unsigned;
#define KSWZ(row, colB) ((row) * 256 + ((colB) ^ (((row) & 15) << 4)))
#define SBAR() __builtin_amdgcn_sched_barrier(0)
__device__ __forceinline__ int crow(int r, int hi) { return (r & 3) + 8 * (r >> 2) + 4 * hi; }
__device__ __forceinline__ unsigned cvtpk(float lo, float hi) {
  unsigned r; asm volatile("v_cvt_pk_bf16_f32 %0, %1, %2" : "=v"(r) : "v"(lo), "v"(hi)); return r;
}
template <typename TIn> struct Stage;
template <> struct Stage<bf16>  { using T = bf16x8;
  __device__ static __forceinline__ T ld8(const bf16* p) { return *reinterpret_cast<const bf16x8*>(p); }
  __device__ static __forceinline__ bf16x8 tobf(T x) { return x; } };
template <> struct Stage<float> { using T = f32x8;
  __device__ static __forceinline__ T ld8(const float* p) { return *reinterpret_cast<const f32x8*>(p); }
  __device__ static __forceinline__ bf16x8 tobf(T x) {
    u32x4 w = {cvtpk(x[0], x[1]), cvtpk(x[2], x[3]), cvtpk(x[4], x[5]), cvtpk(x[6], x[7])}; return *reinterpret_cast<bf16x8*>(&w); } };

__device__ __forceinline__ void partialSM(f32x16& p0, f32x16& p1, float& m_reg, float& mn, float& alpha) {
  constexpr float C = SCALE * 1.4426950408889634f;
  float pmax = p0[0]; for (int r = 1; r < 16; ++r) pmax = fmaxf(pmax, p0[r]); for (int r = 0; r < 16; ++r) pmax = fmaxf(pmax, p1[r]);
  { auto rr = __builtin_amdgcn_permlane32_swap(__float_as_uint(pmax), __float_as_uint(pmax), false, false);
    pmax = fmaxf(__uint_as_float(rr[0]), __uint_as_float(rr[1])); }
  if (__builtin_expect(__all(pmax - m_reg <= THR / SCALE), 1)) { mn = m_reg; alpha = 1.f; }
  else { mn = fmaxf(m_reg, pmax); alpha = __builtin_amdgcn_exp2f((m_reg - mn) * C); m_reg = mn; }
  float mnC = -mn * C;
  for (int r = 0; r < 16; ++r) p0[r] = fmaf(p0[r], C, mnC); for (int r = 0; r < 16; ++r) p1[r] = fmaf(p1[r], C, mnC);
  for (int r = 0; r < 16; ++r) p0[r] = __builtin_amdgcn_exp2f(p0[r]);
}
__device__ __forceinline__ void finishSM(f32x16& p0, f32x16& p1, float alpha, float& l_reg, bf16x8& pa0, bf16x8& pa1, bf16x8& pa2, bf16x8& pa3) {
  for (int r = 0; r < 16; ++r) p1[r] = __builtin_amdgcn_exp2f(p1[r]);
  float ps = 0; for (int r = 0; r < 16; ++r) ps += p0[r]; for (int r = 0; r < 16; ++r) ps += p1[r];
  { auto rr = __builtin_amdgcn_permlane32_swap(__float_as_uint(ps), __float_as_uint(ps), false, false);
    ps = __uint_as_float(rr[0]) + __uint_as_float(rr[1]); }
  l_reg = l_reg * alpha + ps;
#define PK4(P, BASE, OUT) do { unsigned a0 = cvtpk(P[BASE + 0], P[BASE + 1]), a1 = cvtpk(P[BASE + 2], P[BASE + 3]);   \
    unsigned b0 = cvtpk(P[BASE + 4], P[BASE + 5]), b1 = cvtpk(P[BASE + 6], P[BASE + 7]);                              \
    auto r0 = __builtin_amdgcn_permlane32_swap(a0, b0, false, false); auto r1 = __builtin_amdgcn_permlane32_swap(a1, b1, false, false); \
    u32x4 w = {r0[0], r1[0], r0[1], r1[1]}; OUT = *reinterpret_cast<bf16x8*>(&w); } while (0)
  PK4(p0, 0, pa0); PK4(p0, 8, pa1); PK4(p1, 0, pa2); PK4(p1, 8, pa3);
#undef PK4
}
__device__ __forceinline__ void partialSM2(f32x16& p0, f32x16& p1, float mnC) {
  constexpr float C = SCALE * 1.4426950408889634f;
  for (int r = 0; r < 16; ++r) p0[r] = fmaf(p0[r], C, mnC); for (int r = 0; r < 16; ++r) p1[r] = fmaf(p1[r], C, mnC);
  for (int r = 0; r < 16; ++r) p0[r] = __builtin_amdgcn_exp2f(p0[r]);
}
__device__ __forceinline__ void finishSM2(f32x16& p0, f32x16& p1, float& l_reg, bf16x8& pa0, bf16x8& pa1, bf16x8& pa2, bf16x8& pa3) {
  for (int r = 0; r < 16; ++r) p1[r] = __builtin_amdgcn_exp2f(p1[r]);
  float ps = 0; for (int r = 0; r < 16; ++r) ps += p0[r]; for (int r = 0; r < 16; ++r) ps += p1[r];
  { auto rr = __builtin_amdgcn_permlane32_swap(__float_as_uint(ps), __float_as_uint(ps), false, false);
    ps = __uint_as_float(rr[0]) + __uint_as_float(rr[1]); }
  l_reg += ps;
#define PK4(P, BASE, OUT) do { unsigned a0 = cvtpk(P[BASE + 0], P[BASE + 1]), a1 = cvtpk(P[BASE + 2], P[BASE + 3]);   \
    unsigned b0 = cvtpk(P[BASE + 4], P[BASE + 5]), b1 = cvtpk(P[BASE + 6], P[BASE + 7]);                              \
    auto r0 = __builtin_amdgcn_permlane32_swap(a0, b0, false, false); auto r1 = __builtin_amdgcn_permlane32_swap(a1, b1, false, false); \
    u32x4 w = {r0[0], r1[0], r0[1], r1[1]}; OUT = *reinterpret_cast<bf16x8*>(&w); } while (0)
  PK4(p0, 0, pa0); PK4(p0, 8, pa1); PK4(p1, 0, pa2); PK4(p1, 8, pa3);
#undef PK4
}
__device__ __forceinline__ void qkt(f32x16& p0, f32x16& p1, const bf16* Ks, const bf16x8* qr, int r32, int hi) {
  p0 = f32x16{}; p1 = f32x16{};
  for (int d0 = 0; d0 < 8; ++d0) { int cb = (d0 * 16 + hi * 8) * 2;
    bf16x8 b0 = *reinterpret_cast<const bf16x8*>((const char*)Ks + KSWZ(r32, cb));
    bf16x8 b1 = *reinterpret_cast<const bf16x8*>((const char*)Ks + KSWZ(32 + r32, cb));
    p0 = __builtin_amdgcn_mfma_f32_32x32x16_bf16(b0, qr[d0], p0, 0, 0, 0);
    p1 = __builtin_amdgcn_mfma_f32_32x32x16_bf16(b1, qr[d0], p1, 0, 0, 0); }
}
__device__ __forceinline__ int v_st(int k, int c) { const int kk = (k & ~0xC) | ((k & 4) << 1) | ((k & 8) >> 1); return ((kk >> 3) * 4 + (c >> 5)) * 512 + ((kk & 7) * 32 + (c & 31)) * 2; }
__device__ __forceinline__ int v_rd_base(int lane) { return ((lane & 3) << 3) | (((lane >> 2) & 3) << 6) | (((lane >> 4) & 1) << 5) | (((lane >> 5) & 1) << 8); }
constexpr int v_rd_off(int d0, int ks, int half) { return d0 * 512 + ks * 4096 + half * 2048; }
template <int OFF> __device__ __forceinline__ s16x4 tr_read(int vb) {
  s16x4 r; asm volatile("ds_read_b64_tr_b16 %0, %1 offset:%2" : "=&v"(r) : "v"(vb), "i"(OFF) : "memory"); return r;
}
template <int D0> __device__ __forceinline__ void pv_one(f32x16& od, int vb, bf16x8 pa0, bf16x8 pa1, bf16x8 pa2, bf16x8 pa3) {
  const s16x4 l0 = tr_read<v_rd_off(D0, 0, 0)>(vb), h0 = tr_read<v_rd_off(D0, 0, 1)>(vb), l1 = tr_read<v_rd_off(D0, 1, 0)>(vb), h1 = tr_read<v_rd_off(D0, 1, 1)>(vb);
  const s16x4 l2 = tr_read<v_rd_off(D0, 2, 0)>(vb), h2 = tr_read<v_rd_off(D0, 2, 1)>(vb), l3 = tr_read<v_rd_off(D0, 3, 0)>(vb), h3 = tr_read<v_rd_off(D0, 3, 1)>(vb);
  asm volatile("s_waitcnt lgkmcnt(0)" ::: "memory"); SBAR();
#define PK(L, H) (bf16x8){L[0], L[1], L[2], L[3], H[0], H[1], H[2], H[3]}
  od = __builtin_amdgcn_mfma_f32_32x32x16_bf16(pa0, PK(l0, h0), od, 0, 0, 0);
  od = __builtin_amdgcn_mfma_f32_32x32x16_bf16(pa1, PK(l1, h1), od, 0, 0, 0);
  od = __builtin_amdgcn_mfma_f32_32x32x16_bf16(pa2, PK(l2, h2), od, 0, 0, 0);
  od = __builtin_amdgcn_mfma_f32_32x32x16_bf16(pa3, PK(l3, h3), od, 0, 0, 0);
#undef PK
}
__device__ __forceinline__ void pv_d0(f32x16* o, int vb, bf16x8 pa0, bf16x8 pa1, bf16x8 pa2, bf16x8 pa3) {
  pv_one<0>(o[0], vb, pa0, pa1, pa2, pa3); pv_one<1>(o[1], vb, pa0, pa1, pa2, pa3); pv_one<2>(o[2], vb, pa0, pa1, pa2, pa3); pv_one<3>(o[3], vb, pa0, pa1, pa2, pa3);
}
template <typename TQ>
__device__ __forceinline__ void attn_dense_body(const TQ* __restrict__ Qb, const bf16* __restrict__ Kh, const bf16* __restrict__ Vh,
                                                unsigned* __restrict__ Ob, int seq, char* lds, const float* __restrict__ gq, int tq0, const float* __restrict__ gk, const int mk_wave) {
  using St = Stage<bf16>; using SQ = Stage<TQ>;
  const int lane = (int)__builtin_amdgcn_mbcnt_hi(~0u, __builtin_amdgcn_mbcnt_lo(~0u, 0u)), wid = mk_wave, tid = wid * 64 + lane, r32 = lane & 31, hi = lane >> 5;
  bf16* V_lds = (bf16*)lds; bf16* K_lds = (bf16*)(lds + 2 * SHM_V);
  float* ws = (float*)(lds + 2 * SHM_V + 2 * SHM_K) + wid * 64; float* li_l = ws; float* al_l = ws + 32;
  float l_reg = 0; f32x16 o[4] = {}; bf16x8 qr[8];
  float mnC;
  { float a = fmaxf(fabsf(gq[lane]), fabsf(gq[lane + 64])), b = fmaxf(fabsf(gk[lane]), fabsf(gk[lane + 64]));
#pragma unroll
    for (int o_ = 1; o_ < 64; o_ <<= 1) { a = fmaxf(a, __shfl_xor(a, o_)); b = fmaxf(b, __shfl_xor(b, o_)); }
    mnC = -(128.0f * a * b) * (SCALE * 1.4426950408889634f); }
  const TQ* Qw = Qb + (long)(wid * QBLK + r32) * LDQ + hi * 8;
#pragma unroll
  for (int d0 = 0; d0 < 8; ++d0) qr[d0] = SQ::tobf(SQ::ld8(Qw + d0 * 16));
  {
    float ss = 0.f;
#pragma unroll
    for (int d0 = 0; d0 < 8; ++d0)
#pragma unroll
      for (int j = 0; j < 8; ++j) { const float x = __uint_as_float(((unsigned)(unsigned short)qr[d0][j]) << 16); ss += x * x; }
    ss += __shfl_xor(ss, 32);
    const float rstd = 1.0f / sqrtf(ss * (1.f / 128.f) + 1e-6f);
    const int tq = tq0 + wid * QBLK + r32;
    int hio = hi * 8; asm volatile("" : "+v"(hio));
#pragma unroll
    for (int ax = 0; ax < 2; ++ax) { const float pos = (float)(ax == 0 ? (tq >> 6) : (tq & 63));
#pragma unroll
      for (int dd = 0; dd < 2; ++dd) { const int da = ax * 4 + dd, db = da + 2;
        const f32x8 ga = *reinterpret_cast<const f32x8*>(gq + da * 16 + hi * 8), gb = *reinterpret_cast<const f32x8*>(gq + db * 16 + hi * 8);
        float oa[8], ob[8];
#pragma unroll
        for (int j = 0; j < 8; ++j) { const float rev = pos * (__builtin_amdgcn_exp2f(-(float)(dd * 16 + hio + j) * 0.41524101186092029f) * 0.15915494309189535f);
          const float cs = __builtin_amdgcn_cosf(rev), sn = __builtin_amdgcn_sinf(rev);
          const float x1 = __uint_as_float(((unsigned)(unsigned short)qr[da][j]) << 16) * rstd * ga[j], x2 = __uint_as_float(((unsigned)(unsigned short)qr[db][j]) << 16) * rstd * gb[j];
          oa[j] = x1 * cs - x2 * sn; ob[j] = x2 * cs + x1 * sn; }
        u32x4 wa = {cvtpk(oa[0], oa[1]), cvtpk(oa[2], oa[3]), cvtpk(oa[4], oa[5]), cvtpk(oa[6], oa[7])}, wb = {cvtpk(ob[0], ob[1]), cvtpk(ob[2], ob[3]), cvtpk(ob[4], ob[5]), cvtpk(ob[6], ob[7])};
        qr[da] = *reinterpret_cast<bf16x8*>(&wa); qr[db] = *reinterpret_cast<bf16x8*>(&wb);
        asm volatile("" : "+v"(qr[da]), "+v"(qr[db])); } }
  }
  const int sr = tid >> 4, sc = (tid & 15) * 8, vst0 = v_st(sr, sc), vst1 = v_st(32 + sr, sc);
  const int vb0 = (int)(uintptr_t)V_lds + v_rd_base(lane);
  struct { typename St::T vs0, vs1, ks0, ks1; } sr_[SDEPTH];
#define SLOAD(i, k0) do { sr_[i].vs0 = St::ld8(&Vh[(long)((k0) + sr) * LDK + sc]); sr_[i].vs1 = St::ld8(&Vh[(long)((k0) + 32 + sr) * LDK + sc]); \
    sr_[i].ks0 = St::ld8(&Kh[(long)((k0) + sr) * LDK + sc]); sr_[i].ks1 = St::ld8(&Kh[(long)((k0) + 32 + sr) * LDK + sc]); } while (0)
#define SWRITE(b, i) do { *(bf16x8*)((char*)V_lds + (b) * SHM_V + vst0) = St::tobf(sr_[i].vs0);          \
    *(bf16x8*)((char*)V_lds + (b) * SHM_V + vst1) = St::tobf(sr_[i].vs1); int kc = sc * 2;               \
    *(bf16x8*)((char*)K_lds + (b) * SHM_K + KSWZ(sr, kc)) = St::tobf(sr_[i].ks0);                       \
    *(bf16x8*)((char*)K_lds + (b) * SHM_K + KSWZ(32 + sr, kc)) = St::tobf(sr_[i].ks1); } while (0)
#define SWAIT() do { if constexpr (SDEPTH == 2) asm volatile("s_waitcnt vmcnt(4)" ::: "memory"); else asm volatile("s_waitcnt vmcnt(0)" ::: "memory"); } while (0)
#define RESC(a) do { if (__any((a) < 1.f)) { if (hi == 0) al_l[r32] = (a); asm volatile("s_waitcnt lgkmcnt(0)" ::: "memory"); \
    for (int d = 0; d < 4; ++d) for (int r = 0; r < 16; ++r) o[d][r] *= al_l[crow(r, hi)]; } } while (0)
  f32x16 pA0, pA1, pB0, pB1; float mnA, mnB, alA, alB; bf16x8 pa0, pa1, pa2, pa3; const int NT = seq / KVBLK;
  constexpr int SE = 0, SO = SDEPTH - 1;
  SLOAD(SE, 0); asm volatile("s_waitcnt vmcnt(0)" ::: "memory"); SWRITE(0, SE); __syncthreads();
  qkt(pA0, pA1, K_lds, qr, r32, hi); partialSM2(pA0, pA1, mnC);
  SLOAD(SO, KVBLK); if constexpr (SDEPTH == 2) { if (2 < NT) SLOAD(SE, 2 * KVBLK); }
  SWAIT(); SWRITE(1, SO); __syncthreads();
  for (int j = 1; j + 1 < NT; j += 2) {
    SBAR(); qkt(pB0, pB1, (bf16*)((char*)K_lds + SHM_K), qr, r32, hi);
    finishSM2(pA0, pA1, l_reg, pa0, pa1, pa2, pa3); SBAR();
    SLOAD(SO, (j + SDEPTH) * KVBLK); SBAR();
    pv_d0(o, vb0, pa0, pa1, pa2, pa3); partialSM2(pB0, pB1, mnC);
    __syncthreads(); SWAIT(); SWRITE(0, SE);
    __syncthreads();
    SBAR(); qkt(pA0, pA1, K_lds, qr, r32, hi);
    finishSM2(pB0, pB1, l_reg, pa0, pa1, pa2, pa3); SBAR();
    if (SDEPTH == 1 || j + 3 < NT) SLOAD(SE, (j + 1 + SDEPTH) * KVBLK); SBAR();
    pv_d0(o, vb0 + (int)SHM_V, pa0, pa1, pa2, pa3); partialSM2(pA0, pA1, mnC);
    __syncthreads(); SWAIT(); SWRITE(1, SO);
    __syncthreads();
  }
  SBAR(); qkt(pB0, pB1, (bf16*)((char*)K_lds + SHM_K), qr, r32, hi);
  finishSM2(pA0, pA1, l_reg, pa0, pa1, pa2, pa3); SBAR();
  pv_d0(o, vb0, pa0, pa1, pa2, pa3); partialSM2(pB0, pB1, mnC);
  __syncthreads();
  finishSM2(pB0, pB1, l_reg, pa0, pa1, pa2, pa3); SBAR();
  pv_d0(o, vb0 + (int)SHM_V, pa0, pa1, pa2, pa3);
  int lane_e = lane; asm volatile("" : "+v"(lane_e));
  const int r32e = lane_e & 31, hie = lane_e >> 5;
  if (hie == 0) li_l[r32e] = l_reg; asm volatile("s_waitcnt lgkmcnt(0)" ::: "memory");
  float rli[16];
#pragma unroll
  for (int r = 0; r < 16; ++r) rli[r] = __builtin_amdgcn_rcpf(li_l[crow(r, hie)]);
  unsigned* Ow = Ob + (long)(wid * QBLK) * (LDO / 2);
#pragma unroll
  for (int r = 0; r < 16; r += 2) {
#pragma unroll
    for (int d0 = 0; d0 < 4; ++d0) {
      const float x = o[d0][r] * rli[r], y = o[d0][r + 1] * rli[r + 1];
      const float snd = (lane_e & 1) ? x : y; const float rcv = __shfl_xor(snd, 1);
      const unsigned w = (lane_e & 1) ? cvtpk(rcv, y) : cvtpk(x, rcv);
      const int orow = crow((lane_e & 1) ? r + 1 : r, hie);
      Ow[(long)orow * (LDO / 2) + ((d0 * 32 + (r32e & ~1)) >> 1)] = w; } }
  __syncthreads();
#undef SLOAD
#undef SWRITE
#undef SWAIT
#undef RESC
}
}

#ifndef MK_PER_PHASE
#define MK_PER_PHASE 0
#endif
#define LAS __attribute__((address_space(3)))
typedef unsigned short bf16r;
typedef float f32x4g __attribute__((ext_vector_type(4)));
typedef unsigned u32x4g __attribute__((ext_vector_type(4)));
typedef unsigned u32x2g __attribute__((ext_vector_type(2)));
constexpr size_t MiB = 1u << 20;
constexpr size_t WS_WIN = 2 * MiB, WS_WPOOL = 12 * MiB, WS_WOUT = 13 * MiB, WS_WUP = 21 * MiB, WS_WDOWN = 65 * MiB;
constexpr size_t WS_XN = 96 * MiB;
constexpr size_t WS_Z = 288 * MiB;
constexpr size_t WS_D = 528 * MiB;
constexpr size_t WS_AM = 624 * MiB;
constexpr size_t WS_ACT = 288 * MiB;
constexpr size_t WS_HS = 816 * MiB, WS_HV = 825 * MiB, WS_HG = 834 * MiB, WS_SS = 843 * MiB, WS_RSTD = 845 * MiB, WS_END = 846 * MiB;
static_assert(WS_WDOWN + (size_t)2048 * 5632 * 2 <= WS_XN && WS_XN + (size_t)M_ALL * 2048 * 2 <= WS_Z && WS_Z + (size_t)M_ALL * 2560 * 2 <= WS_D && WS_D + (size_t)M_ALL * 1024 * 2 <= WS_AM &&
              WS_AM + (size_t)M_ALL * 2048 * 2 <= WS_HS && WS_ACT + (size_t)M_ALL * 5632 * 2 <= WS_HS && WS_HS + (size_t)192 * 2 * 5632 * 4 <= WS_HV, "d_ws map");
constexpr int RING_BYTES = 131072, XCH_OFF = RING_BYTES, XBST_OFF = RING_BYTES + 12288, LDS_BYTES = 147456;
constexpr size_t WS_BAR = 0;
constexpr int N_PHASES = 9;

__device__ __forceinline__ float wave_sum(float v) {
#pragma unroll
    for (int o = 1; o < 64; o <<= 1) v += __shfl_xor(v, o);
    return v;
}
__device__ __forceinline__ float bf_lo(unsigned w) { return __uint_as_float(w << 16); }
__device__ __forceinline__ float bf_hi(unsigned w) { return __uint_as_float(w & 0xffff0000u); }
#define LDS_WAIT() asm volatile("s_waitcnt lgkmcnt(0)" ::: "memory")

template <int MODE> __device__ __forceinline__ void transpose_item(const float* W, int K, int N, bf16r* WT, int row_off, LAS float* scr, int item, int lane, const float* kscale = nullptr) {
    const int nblk = N / 32, kb = item / nblk, nb = item % nblk, k0 = 64 * kb, n0 = 32 * nb;
    float tv[32];
#pragma unroll
    for (int i = 0; i < 32; ++i) { const int kk = 2 * i + (lane >> 5); tv[i] = W[(size_t)(k0 + kk) * N + n0 + (lane & 31)]; }
    if (MODE == 1) {
        float ks[32];
#pragma unroll
        for (int i = 0; i < 32; ++i) ks[i] = kscale[k0 + 2 * i + (lane >> 5)];
#pragma unroll
        for (int i = 0; i < 32; ++i) tv[i] *= ks[i];
    }
#pragma unroll
    for (int i = 0; i < 32; ++i) { const int kk = 2 * i + (lane >> 5); scr[kk * 33 + (lane & 31)] = tv[i]; }
    LDS_WAIT(); asm volatile("" ::: "memory");
    int d0 = row_off + n0;
    if (MODE == 1) d0 = n0 < 5632 ? 256 * (n0 / 128) + (n0 % 128) : 256 * ((n0 - 5632) / 128) + 128 + ((n0 - 5632) % 128);
    const int c = lane & 7;
#pragma unroll
    for (int j = 0; j < 4; ++j) { const int n = (lane >> 3) + 8 * j; const LAS float* s = scr + (8 * c) * 33 + n;
        u32x4g o; o.x = pg8::cvt_pk_bf16(s[0 * 33], s[1 * 33]); o.y = pg8::cvt_pk_bf16(s[2 * 33], s[3 * 33]); o.z = pg8::cvt_pk_bf16(s[4 * 33], s[5 * 33]); o.w = pg8::cvt_pk_bf16(s[6 * 33], s[7 * 33]);
        *(u32x4g*)(WT + (size_t)(d0 + n) * K + k0 + 8 * c) = o; }
    LDS_WAIT(); asm volatile("" ::: "memory");
}
__device__ __forceinline__ void rms_rows_to_bf16(const float* x_p, const float* x_s, const float* g, bf16r* xn, int gw, int NGW, int lane) {
    f32x4g gv[8], cur[8], nxt[8];
    const f32x4g* gr = (const f32x4g*)g + lane;
#pragma unroll
    for (int j = 0; j < 8; ++j) gv[j] = gr[64 * j];
    int m = gw;
    if (m < M_ALL) { const f32x4g* xr = (const f32x4g*)(m < M_P ? x_p + (size_t)m * 2048 : x_s + (size_t)(m - M_P) * 2048) + lane;
#pragma unroll
        for (int j = 0; j < 8; ++j) cur[j] = xr[64 * j]; }
    for (; m < M_ALL; m += NGW) {
        const int mn = m + NGW;
        if (mn < M_ALL) { const f32x4g* xr = (const f32x4g*)(mn < M_P ? x_p + (size_t)mn * 2048 : x_s + (size_t)(mn - M_P) * 2048) + lane;
#pragma unroll
            for (int j = 0; j < 8; ++j) nxt[j] = xr[64 * j]; }
        float s = 0.f;
#pragma unroll
        for (int j = 0; j < 8; ++j) s += (cur[j].x * cur[j].x + cur[j].y * cur[j].y) + (cur[j].z * cur[j].z + cur[j].w * cur[j].w);
        const float rstd = 1.0f / sqrtf(wave_sum(s) * (1.f / 2048.f) + RMS_EPS);
        u32x2g* o8 = (u32x2g*)(xn + (size_t)m * 2048) + lane;
#pragma unroll
        for (int j = 0; j < 8; ++j) { const f32x4g y = cur[j] * rstd * gv[j]; u32x2g w; w.x = pg8::cvt_pk_bf16(y.x, y.y); w.y = pg8::cvt_pk_bf16(y.z, y.w); o8[64 * j] = w; }
#pragma unroll
        for (int j = 0; j < 8; ++j) cur[j] = nxt[j];
    }
}
template <int HW> __device__ __forceinline__ void pool_item(const bf16r* vcol  , int t0, int L, const float* sc8, bf16r* ocol  ) {
    constexpr int RB = 8, NR = 2 * HW + RB - 1;
    u32x4g rows[NR];
#pragma unroll
    for (int j = 0; j < NR; ++j) { const int t = t0 - HW + j; rows[j] = (t >= 0 && t < L) ? *(const u32x4g*)(vcol + (size_t)t * N_IN) : (u32x4g){0u, 0u, 0u, 0u}; }
    const f32x4g sa = *(const f32x4g*)sc8, sb = *(const f32x4g*)(sc8 + 4);
    float S[8] = {0.f, 0.f, 0.f, 0.f, 0.f, 0.f, 0.f, 0.f};
#define POOL_ACC(R, SGN) do { S[0] += SGN bf_lo(R.x); S[1] += SGN bf_hi(R.x); S[2] += SGN bf_lo(R.y); S[3] += SGN bf_hi(R.y); S[4] += SGN bf_lo(R.z); S[5] += SGN bf_hi(R.z); S[6] += SGN bf_lo(R.w); S[7] += SGN bf_hi(R.w); } while (0)
#pragma unroll
    for (int j = 0; j < 2 * HW; ++j) POOL_ACC(rows[j], +);
#pragma unroll
    for (int i = 0; i < RB; ++i) { const int t = t0 + i; const int lo = t - HW < 0 ? 0 : t - HW, hi = t + HW > L ? L : t + HW; const float rc = 1.0f / (float)(hi - lo);
        const u32x4g U = rows[i + HW];
        u32x4g O; O.x = pg8::cvt_pk_bf16((S[0] * rc - bf_lo(U.x)) * sa.x, (S[1] * rc - bf_hi(U.x)) * sa.y); O.y = pg8::cvt_pk_bf16((S[2] * rc - bf_lo(U.y)) * sa.z, (S[3] * rc - bf_hi(U.y)) * sa.w);
        O.z = pg8::cvt_pk_bf16((S[4] * rc - bf_lo(U.z)) * sb.x, (S[5] * rc - bf_hi(U.z)) * sb.y); O.w = pg8::cvt_pk_bf16((S[6] * rc - bf_lo(U.w)) * sb.z, (S[7] * rc - bf_hi(U.w)) * sb.w);
        *(u32x4g*)(ocol + (size_t)i * 2048) = O;
        if (i < RB - 1) { POOL_ACC(rows[i + 2 * HW], +); POOL_ACC(rows[i], -); } }
#undef POOL_ACC
}
__device__ __forceinline__ void fold_pool_item(const float* w_in, const float* w_pool, bf16r* WT, LAS float* scr, int item, int lane) {
    const int g = item >> 9, kb = (item >> 2) & 127, db = item & 3, k0 = kb * 16, d0 = db * 64;
    f32x4g av[16];
#pragma unroll
    for (int kk = 0; kk < 16; ++kk) av[kk] = *(const f32x4g*)(w_in + (size_t)(k0 + kk) * N_IN + 1536 + g * 256 + lane * 4);
#pragma unroll
    for (int kk = 0; kk < 16; ++kk) *(LAS f32x4g*)(scr + kk * 256 + lane * 4) = av[kk];
    LDS_WAIT(); asm volatile("" ::: "memory");
    const float* bp = w_pool + (size_t)g * 65536 + d0 + lane;
    float acc[16];
#pragma unroll
    for (int kk = 0; kk < 16; ++kk) acc[kk] = 0.f;
#pragma unroll 2
    for (int c = 0; c < 256; c += 4) {
        const float b0 = bp[(size_t)(c + 0) * 256], b1 = bp[(size_t)(c + 1) * 256], b2 = bp[(size_t)(c + 2) * 256], b3 = bp[(size_t)(c + 3) * 256];
#pragma unroll
        for (int kk = 0; kk < 16; ++kk) { const f32x4g a = *(const LAS f32x4g*)(scr + kk * 256 + c); acc[kk] += a.x * b0 + a.y * b1 + a.z * b2 + a.w * b3; }
    }
    u32x4g o0, o1;
    o0.x = pg8::cvt_pk_bf16(acc[0], acc[1]); o0.y = pg8::cvt_pk_bf16(acc[2], acc[3]); o0.z = pg8::cvt_pk_bf16(acc[4], acc[5]); o0.w = pg8::cvt_pk_bf16(acc[6], acc[7]);
    o1.x = pg8::cvt_pk_bf16(acc[8], acc[9]); o1.y = pg8::cvt_pk_bf16(acc[10], acc[11]); o1.z = pg8::cvt_pk_bf16(acc[12], acc[13]); o1.w = pg8::cvt_pk_bf16(acc[14], acc[15]);
    bf16r* orow = WT + (size_t)(1536 + g * 256 + d0 + lane) * 2048 + k0;
    *(u32x4g*)orow = o0; *(u32x4g*)(orow + 8) = o1;
    LDS_WAIT(); asm volatile("" ::: "memory");
}
#define XB_TMO      128
#define XB_XCNT(j)  (256  + 64 * (j))
#define XB_XSUB(j)  (1280 + 64 * (j))
#define XB_XGEN(j)  (2304 + 64 * (j))
#define XB_TOP      3328
#define XB_TOPGEN   3392
#define XCD_BAR_WORDS 3456
#define XB_SPIN_CAP (1u << 18)

__device__ __forceinline__ unsigned xb_ld(unsigned* p)              { return __hip_atomic_load(p, __ATOMIC_RELAXED, __HIP_MEMORY_SCOPE_AGENT); }
__device__ __forceinline__ unsigned xb_add(unsigned* p, unsigned v) { return __hip_atomic_fetch_add(p, v, __ATOMIC_RELAXED, __HIP_MEMORY_SCOPE_AGENT); }
__device__ __forceinline__ unsigned xb_xcc_id() { return (unsigned)__builtin_amdgcn_s_getreg((3 << 11) | 20) & 0xFu; }
#define XB_SPIN(cond, bar) do { unsigned _sp = 0; while (cond) { __builtin_amdgcn_s_sleep(1); \
    if ((++_sp & 255u) == 0u) { if (xb_ld(&(bar)[XB_TMO])) break; if (_sp > XB_SPIN_CAP) { atomicAdd(&(bar)[XB_TMO], 1u); break; } } } } while (0)

struct XcdBarrier {
    unsigned* bar; unsigned x;
    volatile __attribute__((address_space(3))) unsigned* st;
};

__device__ __forceinline__ XcdBarrier xcd_barrier_post(unsigned* bar, volatile __attribute__((address_space(3))) unsigned* st, bool leader) {
    XcdBarrier b; b.bar = bar; b.x = xb_xcc_id(); b.st = st;
    if (leader) (void)xb_add(&bar[XB_XCNT(b.x)], 1u);
    return b;
}
__device__ __forceinline__ void xcd_barrier_complete(unsigned* bar, unsigned x, unsigned& nloc, unsigned& nx) {
    const unsigned G = gridDim.x * gridDim.y * gridDim.z;
    unsigned sum, cnt, mine, sp = 0u;
    for (;;) {
        sum = 0u; cnt = 0u; mine = 0u;
#pragma unroll
        for (unsigned j = 0; j < 16; ++j) { const unsigned c = xb_ld(&bar[XB_XCNT(j)]); sum += c; cnt += (c > 0u) ? 1u : 0u; mine = (j == x) ? c : mine; }
        if (sum == G) break;
        __builtin_amdgcn_s_sleep(1);
        if ((++sp & 255u) == 0u) { if (xb_ld(&bar[XB_TMO])) break; if (sp > XB_SPIN_CAP) { atomicAdd(&bar[XB_TMO], 1u); break; } }
    }
    nloc = mine > 0u ? mine : 1u; nx = cnt > 0u ? cnt : 1u;
}

__device__ __attribute__((noinline)) void xcd_barrier(unsigned* bar_, unsigned x_, volatile __attribute__((address_space(3))) unsigned* st_, bool leader) {
    XcdBarrier b; b.bar = bar_; b.x = x_; b.st = st_;
    asm volatile("s_waitcnt vmcnt(0)" ::: "memory");
    __syncthreads();
    if (leader) {
        unsigned* bar = b.bar;
        __builtin_amdgcn_s_waitcnt(0);
        unsigned nloc = b.st[0], nx = b.st[1];
        if (nloc == 0u) { xcd_barrier_complete(bar, b.x, nloc, nx); b.st[0] = nloc; b.st[1] = nx; }
        const unsigned old = xb_add(&bar[XB_XSUB(b.x)], 1u);
        const unsigned gen = old / nloc;
        if (old + 1u == (gen + 1u) * nloc) {
            __builtin_amdgcn_fence(__ATOMIC_RELEASE, "agent");
            asm volatile("s_waitcnt vmcnt(0)" ::: "memory");
            const unsigned og = xb_add(&bar[XB_TOP], 1u);
            const unsigned tg = og / nx;
            if (og + 1u == (tg + 1u) * nx) xb_add(&bar[XB_TOPGEN], 1u);
            else XB_SPIN(xb_ld(&bar[XB_TOPGEN]) == tg, bar);
            __builtin_amdgcn_fence(__ATOMIC_ACQUIRE, "agent");
            xb_add(&bar[XB_XGEN(b.x)], 1u);
            asm volatile("s_waitcnt vmcnt(0)" ::: "memory");
        } else {
            XB_SPIN(xb_ld(&bar[XB_XGEN(b.x)]) == gen, bar);
            __builtin_amdgcn_fence(__ATOMIC_ACQUIRE, "agent");
            asm volatile("s_waitcnt vmcnt(0)" ::: "memory");
        }
    }
    __syncthreads();
}
__device__ __attribute__((noinline)) void grid_sync_fn() { cg::this_grid().sync(); }

struct Args { const float* in[14]; float* out; unsigned char* ws; int ph_lo, ph_hi; };
typedef const __attribute__((address_space(4))) Args* KArgs;
__device__ __forceinline__ KArgs kargs() { KArgs p = (KArgs)__builtin_amdgcn_kernarg_segment_ptr(); asm volatile("" : "+s"(p)); return p; }

__global__ void __launch_bounds__(512, 2) fwd_megakernel(Args args) {
    extern __shared__ __attribute__((aligned(16))) unsigned char lds[];
    const int wave = __builtin_amdgcn_readfirstlane((int)threadIdx.x >> 6);
    const int lane = (int)__builtin_amdgcn_mbcnt_hi(~0u, __builtin_amdgcn_mbcnt_lo(~0u, 0u)), tid = wave * 64 + lane;
    const int G = gridDim.x, bx = blockIdx.x;
#define KA_WS (kargs()->ws)
#define KA_IN(i) (kargs()->in[i])
#define KA_OUT (kargs()->out)
#define Win_t ((bf16r*)(KA_WS + WS_WIN))
#define Wpool_t ((bf16r*)(KA_WS + WS_WPOOL))
#define Wout_t ((bf16r*)(KA_WS + WS_WOUT))
#define Wup_t ((bf16r*)(KA_WS + WS_WUP))
#define Wdown_t ((bf16r*)(KA_WS + WS_WDOWN))
#define XN ((bf16r*)(KA_WS + WS_XN))
#define Z ((bf16r*)(KA_WS + WS_Z))
#define Dp ((bf16r*)(KA_WS + WS_D))
#define AM ((bf16r*)(KA_WS + WS_AM))
#define ACT ((bf16r*)(KA_WS + WS_ACT))
#define HS ((float*)(KA_WS + WS_HS))
#define HV ((float*)(KA_WS + WS_HV))
#define HG ((float*)(KA_WS + WS_HG))
#define SSQ ((float*)(KA_WS + WS_SS))
#define RSTD ((float*)(KA_WS + WS_RSTD))
    LAS unsigned char* ldsl = (LAS unsigned char*)lds;
    const int lo = kargs()->ph_lo, hi = kargs()->ph_hi;
#ifndef PHASE_MASK
#define PHASE_MASK 0x1ff
#endif
#define IN(k) (((PHASE_MASK >> (k)) & 1) && lo <= (k) && (k) < hi)
#ifndef PROBE_DUP
#define PROBE_DUP 0
#endif
#define NREP(k) (((PROBE_DUP >> (k)) & 1) ? 2 : 1)
#if MK_PER_PHASE
#define SEAM(k) do { } while (0)
#else
    volatile LAS unsigned* xbst = (volatile LAS unsigned*)(ldsl + XBST_OFF);
    if (tid == 0) { xbst[0] = 0u; xbst[1] = 0u; }
    unsigned xb_x = 0;
#define SEAM(k) do { if (IN(k) && IN((k) + 1)) { if ((k) == 0) { grid_sync_fn(); xb_x = xcd_barrier_post((unsigned*)(KA_WS + WS_BAR), xbst, tid == 0).x; } else { int ln_; asm volatile("v_mbcnt_lo_u32_b32 %0, -1, 0\n\tv_mbcnt_hi_u32_b32 %0, -1, %0" : "=v"(ln_)); xcd_barrier((unsigned*)(KA_WS + WS_BAR), xb_x, xbst, (wave == 0) && (ln_ == 0)); } } } while (0)
#endif
    const int gw = bx * 8 + wave, NGW = G * 8;
    const int gt = bx * 512 + tid, NGT = G * 512;

    if (IN(0)) {
        LAS float* scr = (LAS float*)(ldsl + wave * 16384);
        if (bx == 0) { unsigned* bw = (unsigned*)(KA_WS + WS_BAR); for (int i = tid; i < XCD_BAR_WORDS; i += 512) bw[i] = 0u; }
        constexpr int I_IN = 32 * 48  , I_FOLD = 4 * 32 * 16, I_OUT = 32 * 64;
        constexpr int NITEMS = I_IN + I_FOLD + I_OUT;
        const float* w_in = KA_IN(3); const float* w_out = KA_IN(8); const float* w_pool = KA_IN(6); unsigned char* wsb = KA_WS;
        for (int rp = 0; rp < NREP(0); ++rp) {
        for (int half = 0; half < 2; ++half) {
            const bool do_rows = (half == 0) == ((wave & 1) != 0);
            if (do_rows) { rms_rows_to_bf16(KA_IN(0), KA_IN(1), KA_IN(2), XN, gw, NGW, lane); continue; }
            for (int it = gw; it < NITEMS; it += NGW) {
                int r = it;
                if (r < I_FOLD) { fold_pool_item(w_in, w_pool, (bf16r*)(wsb + WS_WIN), scr, r, lane); continue; } r -= I_FOLD;
                if (r < I_IN) { const int kb = r / 48, nb = r % 48; transpose_item<0>(w_in, 2048, N_IN, (bf16r*)(wsb + WS_WIN), 0, scr, kb * 80 + nb, lane); continue; } r -= I_IN;
                transpose_item<0>(w_out, 2048, 2048, (bf16r*)(wsb + WS_WOUT), 0, scr, r, lane);
            }
        }
        }
    }
    SEAM(0);
#ifdef PROBE_SYNC
    for (int i_ = 0; i_ < PROBE_SYNC; ++i_) grid_sync_fn();
#endif
    if (IN(1)) {
        pg8::Gemm g{XN, Win_t, M_ALL, N_IN, 2048}; pg8::StaticOrder S; S.init(M_ALL, N_IN, G, bx); S.reps = NREP(1);
        pg8::EpiBf16 E{Z, N_IN, 0, 0, nullptr};
        pg8::gemm_phase<pg8::EpiBf16, pg8::StaticOrder, true, true>(ldsl, g, S, E, wave);
        {
            const int remu = (192 * 10) % G, nidle = remu ? G - remu : G, rank = remu ? bx - remu : bx;
            if (rank >= 0) {
                __syncthreads();
                LAS float* scr = (LAS float*)(ldsl + wave * 16384);
                constexpr int I_UP = 32 * 352, I_DOWN = 88 * 64;
                const float* w_up = KA_IN(10); const float* w_down = KA_IN(13); const float* g_ffn = KA_IN(9); unsigned char* wsb = KA_WS;
                for (int it = rank * 8 + wave; it < I_UP + I_DOWN; it += nidle * 8) {
                    if (it < I_UP) transpose_item<1>(w_up, 2048, N_UP, (bf16r*)(wsb + WS_WUP), 0, scr, it, lane, g_ffn);
                    else transpose_item<0>(w_down, D_FF, 2048, (bf16r*)(wsb + WS_WDOWN), 0, scr, it - I_UP, lane);
                }
            }
        }
    }
    SEAM(1);
    if (IN(2)) {
        bf16r* zb = Z; bf16r* amb = AM; const float* gk = KA_IN(5); const float* psc = KA_IN(7);
        const int sub = gt & 7, a = sub >> 2, ch = sub & 3;
        float invf[8];
#pragma unroll
        for (int i = 0; i < 8; ++i) invf[i] = __builtin_amdgcn_exp2f(-(float)(8 * ch + i) * 0.41524101186092029f) * 0.15915494309189535f;
        for (int item = gt >> 3; item < M_ALL * 2; item += NGT >> 3) {
            const int row = item >> 1, hh = 8 + (item & 1);
            const int t = row < M_P ? (row & (L_P - 1)) : ((row - M_P) & (L_S - 1));
            const float pos = (float)(a == 0 ? (t >> 6) : (t & 63));
            bf16r* p = zb + (size_t)row * N_IN + (hh < 8 ? hh * 128 : 1024 + (hh - 8) * 128) + 64 * a + 8 * ch;
            const float* gn = gk + 64 * a + 8 * ch;
            const u32x4g A = *(const u32x4g*)p, B = *(const u32x4g*)(p + 32);
            float x1[8] = {bf_lo(A.x), bf_hi(A.x), bf_lo(A.y), bf_hi(A.y), bf_lo(A.z), bf_hi(A.z), bf_lo(A.w), bf_hi(A.w)};
            float x2[8] = {bf_lo(B.x), bf_hi(B.x), bf_lo(B.y), bf_hi(B.y), bf_lo(B.z), bf_hi(B.z), bf_lo(B.w), bf_hi(B.w)};
            float ss = 0.f;
#pragma unroll
            for (int i = 0; i < 8; ++i) ss += x1[i] * x1[i] + x2[i] * x2[i];
            ss += __shfl_xor(ss, 1); ss += __shfl_xor(ss, 2); ss += __shfl_xor(ss, 4);
            const float rstd = 1.0f / sqrtf(ss * (1.f / 128.f) + RMS_EPS);
            const f32x4g g1a = *(const f32x4g*)gn, g1b = *(const f32x4g*)(gn + 4), g2a = *(const f32x4g*)(gn + 32), g2b = *(const f32x4g*)(gn + 36);
            const float g1[8] = {g1a.x, g1a.y, g1a.z, g1a.w, g1b.x, g1b.y, g1b.z, g1b.w}, g2[8] = {g2a.x, g2a.y, g2a.z, g2a.w, g2b.x, g2b.y, g2b.z, g2b.w};
            float o1[8], o2[8];
#pragma unroll
            for (int i = 0; i < 8; ++i) { const float y1 = x1[i] * rstd * g1[i], y2 = x2[i] * rstd * g2[i]; const float rev = pos * invf[i];
                const float cs = __builtin_amdgcn_cosf(rev), sn = __builtin_amdgcn_sinf(rev); o1[i] = y1 * cs - y2 * sn; o2[i] = y2 * cs + y1 * sn; }
            u32x4g OA, OB; OA.x = pg8::cvt_pk_bf16(o1[0], o1[1]); OA.y = pg8::cvt_pk_bf16(o1[2], o1[3]); OA.z = pg8::cvt_pk_bf16(o1[4], o1[5]); OA.w = pg8::cvt_pk_bf16(o1[6], o1[7]);
            OB.x = pg8::cvt_pk_bf16(o2[0], o2[1]); OB.y = pg8::cvt_pk_bf16(o2[2], o2[3]); OB.z = pg8::cvt_pk_bf16(o2[4], o2[5]); OB.w = pg8::cvt_pk_bf16(o2[6], o2[7]);
            *(u32x4g*)p = OA; *(u32x4g*)(p + 32) = OB;
        }
        for (int rp = 0; rp < NREP(2); ++rp)
        for (int item = gt; item < 4 * (M_ALL / 8) * 32; item += NGT) {
            const int g = item / ((M_ALL / 8) * 32), rem = item - g * ((M_ALL / 8) * 32), rb = rem >> 5, c8 = (rem & 31) * 8, row0 = rb * 8;
            const int L = row0 < M_P ? L_P : L_S, t0 = row0 < M_P ? (row0 & (L_P - 1)) : ((row0 - M_P) & (L_S - 1));
            const bf16r* vcol = zb + (size_t)(row0 - t0) * N_IN + 1536 + g * 256 + c8; bf16r* ocol = amb + (size_t)row0 * 2048 + 1024 + g * 256 + c8; const float* sc8 = psc + g * 256 + c8;
            if (g == 0) pool_item<1>(vcol, t0, L, sc8, ocol); else if (g == 1) pool_item<2>(vcol, t0, L, sc8, ocol); else if (g == 2) pool_item<4>(vcol, t0, L, sc8, ocol); else pool_item<8>(vcol, t0, L, sc8, ocol);
        }
    }
    SEAM(2);
    if (IN(3)) {
        for (int Lu_ = bx; Lu_ < 1536 * NREP(3); Lu_ += G) { const int Lu = Lu_ % 1536;
            const int r = Lu >> 8, cc = Lu & 255, x = cc & 7, slot = cc >> 3, b = x >> 1, kvh = x & 1;
            int head, qb, seq, row0;
            if (r < 4) { head = kvh * 4 + r; qb = slot; seq = L_S; row0 = M_P + b * L_S; }
            else { head = kvh * 4 + (r - 4) * 2 + (slot >> 4); qb = slot & 15; seq = L_P; row0 = b * L_P; }
            const bf16r* zb = Z;
            const att::bf16* Qb = (const att::bf16*)(zb + (size_t)(row0 + qb * 256) * N_IN + head * 128);
            const att::bf16* Kh = (const att::bf16*)(zb + (size_t)row0 * N_IN + 1024 + kvh * 128);
            const att::bf16* Vh = (const att::bf16*)(zb + (size_t)row0 * N_IN + 1280 + kvh * 128);
            unsigned* Ob = (unsigned*)(AM + (size_t)(row0 + qb * 256) * 2048 + head * 128);
            att::attn_dense_body<att::bf16>(Qb, Kh, Vh, Ob, seq, (char*)lds, KA_IN(4), qb * 256, KA_IN(5), wave);
        }
    }
    SEAM(3);
    if (IN(4)) {
        pg8::Gemm g{AM, Wout_t, M_ALL, 2048, 2048}; pg8::StaticOrder S; S.init(M_ALL, 2048, G, bx); S.reps = NREP(4);
        pg8::EpiResNorm E{KA_IN(0), KA_IN(1), XN, SSQ, (LAS float*)(ldsl + XCH_OFF)};
        pg8::gemm_phase<pg8::EpiResNorm, pg8::StaticOrder, true, true>(ldsl, g, S, E, wave);
    }
#ifdef PROBE_X4
    if (IN(4)) { __syncthreads();
        pg8::Gemm g{AM, Wout_t, M_ALL, 2048, 2048}; pg8::StaticOrder S; S.init(M_ALL, 2048, G, bx);
        pg8::EpiBf16 E{ACT, 2048, 0, 0, nullptr};
        pg8::gemm_phase<pg8::EpiBf16, pg8::StaticOrder, true, true>(ldsl, g, S, E, wave);
    }
#endif
    SEAM(4);
    if (IN(5)) {
        const float* ssq = SSQ; float* rstd = RSTD;
        for (int row = gt; row < M_ALL; row += NGT) { float q = 0.f;
#pragma unroll
            for (int p = 0; p < 8; ++p) q += ssq[(size_t)p * M_ALL + row];
            rstd[row] = 1.0f / sqrtf(q * (1.f / 2048.f) + RMS_EPS); }
    }
    SEAM(5);
    if (IN(6)) {
        pg8::Gemm g{XN, Wup_t, M_ALL, N_UP, 2048}; pg8::StaticOrder S; S.init(M_ALL, N_UP, G, bx); S.reps = NREP(6);
        pg8::EpiConvGlu E{ACT, KA_IN(11), KA_IN(12), HS, HV, HG, (LAS float*)(ldsl + XCH_OFF), RSTD};
        pg8::gemm_phase<pg8::EpiConvGlu, pg8::StaticOrder, true, true>(ldsl, g, S, E, wave);
    }
    SEAM(6);
    if (IN(7)) {
        const float* wc = KA_IN(11); const float* hs = HS; const float* hv = HV; const float* hg = HG; bf16r* actb = ACT;
        for (int item = gt; item < N_TILES_M * 2 * (D_FF / 4); item += NGT) {
            const int c4 = (item % (D_FF / 4)) * 4, pe = item / (D_FF / 4), pm = pe >> 1, e = pe & 1;
            const int tps = pm < 64 ? 16 : 32, ti = pm < 64 ? (pm & 15) : ((pm - 64) & 31);
            if (e == 0 ? (ti == 0) : (ti == tps - 1)) continue;
            const size_t ho = (size_t)pe * D_FF + c4;
            const f32x4g s0 = *(const f32x4g*)(hs + ho), v = *(const f32x4g*)(hv + ho);
            const f32x4g gn = e == 0 ? *(const f32x4g*)(hg + ((size_t)(pm - 1) * 2 + 1) * D_FF + c4) : *(const f32x4g*)(hg + ((size_t)(pm + 1) * 2 + 0) * D_FF + c4);
            const f32x4g w = *(const f32x4g*)(wc + (e == 0 ? 0 : 2 * D_FF) + c4);
            const f32x4g s = s0 + w * gn;
            u32x2g o; o.x = pg8::cvt_pk_bf16(pg8::silu_f(s.x) * v.x, pg8::silu_f(s.y) * v.y); o.y = pg8::cvt_pk_bf16(pg8::silu_f(s.z) * v.z, pg8::silu_f(s.w) * v.w);
            *(u32x2g*)(actb + ((size_t)pm * 256 + (e ? 255 : 0)) * D_FF + c4) = o;
        }
    }
    SEAM(7);
    if (IN(8)) {
        pg8::Gemm g{ACT, Wdown_t, M_ALL, 2048, D_FF}; pg8::StaticOrder S; S.init(M_ALL, 2048, G, bx); S.reps = NREP(8);
        pg8::EpiResOut E{XN, KA_OUT};
        pg8::gemm_phase<pg8::EpiResOut, pg8::StaticOrder, true, true>(ldsl, g, S, E, wave);
    }
#undef IN
#undef SEAM
}

extern "C" void kernel_launch(void* const* d_in, const int* in_sizes, int n_in, void* d_out, int out_size, void* d_ws, size_t ws_size, hipStream_t stream) {
    static int grid = 0;
    if (grid == 0) {
        if (n_in != 14 || in_sizes[0] != M_P * 2048 || in_sizes[1] != M_S * 2048 || out_size != M_ALL * 2048 || ws_size < WS_END) {
            fprintf(stderr, "kernel_launch: shape mismatch (n_in %d, in0 %d, in1 %d, out %d, ws %zu; need ws >= %zu)\n", n_in, n_in > 0 ? in_sizes[0] : -1, n_in > 1 ? in_sizes[1] : -1, out_size, ws_size, (size_t)WS_END);
            grid = -1; return; }
        int dev = 0, cus = 0, per_cu = 0;
        if (hipGetDevice(&dev) != hipSuccess || hipDeviceGetAttribute(&cus, hipDeviceAttributeMultiprocessorCount, dev) != hipSuccess) { grid = -1; return; }
        if (hipFuncSetAttribute((const void*)fwd_megakernel, hipFuncAttributeMaxDynamicSharedMemorySize, LDS_BYTES) != hipSuccess) { fprintf(stderr, "kernel_launch: hipFuncSetAttribute failed\n"); grid = -1; return; }
        if (hipOccupancyMaxActiveBlocksPerMultiprocessor(&per_cu, (const void*)fwd_megakernel, 512, LDS_BYTES) != hipSuccess || per_cu < 1) { fprintf(stderr, "kernel_launch: occupancy query gave %d\n", per_cu); per_cu = 1; }
        (void)hipGetLastError();
        grid = cus * 1;
        if (grid <= 0) { grid = -1; return; }
    }
    if (grid < 0) return;
    Args a{};
    for (int i = 0; i < 14; ++i) a.in[i] = (const float*)d_in[i];
    a.out = (float*)d_out; a.ws = (unsigned char*)d_ws;
#if MK_PER_PHASE
    for (int ph = 0; ph < N_PHASES; ++ph) { a.ph_lo = ph; a.ph_hi = ph + 1; hipLaunchKernelGGL(fwd_megakernel, dim3(grid), dim3(512), LDS_BYTES, stream, a); }
#else
    a.ph_lo = 0; a.ph_hi = N_PHASES;
    void* kargs[] = {&a};
    const hipError_t e = hipLaunchCooperativeKernel((const void*)fwd_megakernel, dim3(grid), dim3(512), kargs, LDS_BYTES, stream);
    if (e != hipSuccess) fprintf(stderr, "kernel_launch: cooperative launch failed: %s (grid %d)\n", hipGetErrorString(e), grid);
#endif
}
```

```cpp
#include <hip/hip_runtime.h>
#include <hip/hip_bf16.h>
#include <hip/hip_cooperative_groups.h>
#include <cstdio>
#include <cstdint>
#include <cmath>
namespace cg = cooperative_groups;

constexpr int DMODEL = 2048, M_P = 16384, M_S = 32768, M_ALL = 49152, L_P = 4096, L_S = 8192;
constexpr int N_IN = 2560, D_FF = 5632, N_UP = 11264, N_TILES_M = M_ALL / 256;
constexpr float RMS_EPS = 1e-6f;
namespace pg8 {
#define PG8_LAS __attribute__((address_space(3)))
typedef unsigned short bf16_t;
typedef short bf16x8 __attribute__((ext_vector_type(8)));
typedef float f32x4 __attribute__((ext_vector_type(4)));
typedef unsigned u32x4 __attribute__((ext_vector_type(4)));
constexpr int BM = 256, BK = 64, HALF = 128, HTB = HALF * BK * 2  , STAGE_BYTES = 8 * HTB, NXCD = 8, WGM = 8;

__host__ __device__ __forceinline__ int lds_byte(int r, int c) { const int st = (r >> 4) * 2 + (c >> 5), rr = r & 15, cc = c & 31, ob = rr * 64 + cc * 2; return st * 1024 + (ob ^ (((ob >> 9) & 1) << 5)); }
__host__ __device__ __forceinline__ void stage_rc(int b, int& R, int& C) { const int st = b / 1024, sb = b % 1024, swz = sb ^ (((sb >> 9) & 1) << 5); R = (st >> 1) * 16 + swz / 64; C = (st & 1) * 32 + (swz % 64) / 2; }
__host__ __device__ __forceinline__ int perm32(int rho) { const int n = rho >> 4, i = rho & 15; return 8 * (i >> 2) + 4 * n + (i & 3); }

struct Unit { int pm, pn; };
struct Gemm { const bf16_t* A; const bf16_t* Bt; int M, N, K; };

struct StaticOrder {
    int nM, nN, nwg, G, c, reps;
    __host__ __device__ void init(int M, int N, int G_, int c_) { nM = M / BM; nN = N / BM; nwg = nM * nN; G = G_; c = c_; reps = 1; }
    __host__ __device__ bool next(int i, Unit& u) const {
        const long L = (long)i * G + c; if (L >= (long)nwg * reps) return false;
        int wgid = (int)(L % nwg); { const int q = nwg / NXCD, r = nwg % NXCD, xcd = wgid % NXCD, off = wgid / NXCD; wgid = (xcd < r ? xcd * (q + 1) : r * (q + 1) + (xcd - r) * q) + off; }
        const int nig = WGM * nN, gid = wgid / nig, fm = gid * WGM, gsz = (nM - fm) < WGM ? (nM - fm) : WGM;
        u.pm = fm + ((wgid % nig) % gsz); u.pn = (wgid % nig) / gsz; return true;
    }
    __device__ __forceinline__ void a_ready(const Unit&) const {}
    __device__ __forceinline__ void done(const Unit&) const {}
};
__device__ __forceinline__ unsigned cvt_pk_bf16(float lo, float hi) { unsigned r; asm volatile("v_cvt_pk_bf16_f32 %0, %1, %2" : "=v"(r) : "v"(lo), "v"(hi)); return r; }
typedef float f32x2 __attribute__((ext_vector_type(2)));
constexpr int D_FF_C = 5632;
struct EpiBf16 {
    static constexpr bool PERM = true, AFTER_DRAIN = false;
    bf16_t* O; int ldc; int pm_mod; int col_off; const float* cscale;
    __device__ __forceinline__ void operator()(const f32x4 (&acc)[2][2][4][2], const Unit& u, int wr, int wc, int fr, int fq) const {
        const int pm = pm_mod ? (u.pm % pm_mod) : u.pm;
        const int row0 = pm * BM + wr * 64 + fr; const int lc = u.pn * BM + wc * 32 + 8 * fq;
        f32x4 sv[2][2];
#pragma unroll
        for (int bj = 0; bj < 2; ++bj)
#pragma unroll
            for (int n = 0; n < 2; ++n) sv[bj][n] = cscale ? *(const f32x4*)(cscale + lc + bj * HALF + 4 * n) : (f32x4){1.f, 1.f, 1.f, 1.f};
#pragma unroll
        for (int ai = 0; ai < 2; ++ai)
#pragma unroll
            for (int m = 0; m < 4; ++m) { bf16_t* rowp = O + (size_t)(row0 + ai * HALF + m * 16) * ldc + col_off + lc;
#pragma unroll
                for (int bj = 0; bj < 2; ++bj) { const f32x4 v0 = acc[ai][bj][m][0] * sv[bj][0], v1 = acc[ai][bj][m][1] * sv[bj][1];
                    u32x4 w; w.x = cvt_pk_bf16(v0[0], v0[1]); w.y = cvt_pk_bf16(v0[2], v0[3]); w.z = cvt_pk_bf16(v1[0], v1[1]); w.w = cvt_pk_bf16(v1[2], v1[3]);
                    *(u32x4*)(rowp + bj * HALF) = w; } }
    }
};
struct EpiResOut {
    static constexpr bool PERM = false, AFTER_DRAIN = false;
    const bf16_t* xb; float* out;
    __device__ __forceinline__ void operator()(const f32x4 (&acc)[2][2][4][2], const Unit& u, int wr, int wc, int fr, int fq) const {
        typedef unsigned u32x2 __attribute__((ext_vector_type(2)));
        const int col0 = u.pn * BM + wc * 32 + 4 * fq;
        u32x2 xv[2][4][2][2];
#pragma unroll
        for (int ai = 0; ai < 2; ++ai)
#pragma unroll
            for (int m = 0; m < 4; ++m) { const size_t r = (size_t)u.pm * BM + ai * HALF + wr * 64 + m * 16 + fr;
#pragma unroll
                for (int bj = 0; bj < 2; ++bj)
#pragma unroll
                    for (int n = 0; n < 2; ++n) xv[ai][m][bj][n] = *(const u32x2*)(xb + r * 2048 + col0 + bj * HALF + n * 16); }
#pragma unroll
        for (int ai = 0; ai < 2; ++ai)
#pragma unroll
            for (int m = 0; m < 4; ++m) { const size_t r = (size_t)u.pm * BM + ai * HALF + wr * 64 + m * 16 + fr; float* orow = out + r * 2048;
#pragma unroll
                for (int bj = 0; bj < 2; ++bj)
#pragma unroll
                    for (int n = 0; n < 2; ++n) { const u32x2 w = xv[ai][m][bj][n];
                        const f32x4 b = (f32x4){__uint_as_float(w.x << 16), __uint_as_float(w.x & 0xffff0000u), __uint_as_float(w.y << 16), __uint_as_float(w.y & 0xffff0000u)};
                        *(f32x4*)(orow + col0 + bj * HALF + n * 16) = b + acc[ai][bj][m][n]; } }
    }
};
struct EpiResNorm {
    static constexpr bool PERM = false, AFTER_DRAIN = false;
    const float* xp; const float* xs; bf16_t* xn; float* ss; PG8_LAS float* P;
    __device__ __forceinline__ void operator()(const f32x4 (&acc)[2][2][4][2], const Unit& u, int wr, int wc, int fr, int fq) const {
        typedef unsigned u32x2 __attribute__((ext_vector_type(2)));
        const int col0 = u.pn * BM + wc * 32 + 4 * fq;
#pragma unroll
        for (int ai = 0; ai < 2; ++ai) {
            f32x4 xv[4][2][2];
#pragma unroll
            for (int m = 0; m < 4; ++m) { const int r = u.pm * BM + ai * HALF + wr * 64 + m * 16 + fr;
                const float* xr = r < 16384 ? xp + (size_t)r * 2048 : xs + (size_t)(r - 16384) * 2048;
#pragma unroll
                for (int bj = 0; bj < 2; ++bj)
#pragma unroll
                    for (int n = 0; n < 2; ++n) xv[m][bj][n] = __builtin_nontemporal_load((const f32x4*)(xr + col0 + bj * HALF + n * 16)); }
            asm volatile("" ::: "memory");
#pragma unroll
            for (int m = 0; m < 4; ++m) { const int rl = ai * HALF + wr * 64 + m * 16 + fr, r = u.pm * BM + rl;
                bf16_t* nrow = xn + (size_t)r * 2048; float sq = 0.f;
#pragma unroll
                for (int bj = 0; bj < 2; ++bj)
#pragma unroll
                    for (int n = 0; n < 2; ++n) { const int c = col0 + bj * HALF + n * 16; const f32x4 v = xv[m][bj][n] + acc[ai][bj][m][n];
                        sq += (v[0] * v[0] + v[1] * v[1]) + (v[2] * v[2] + v[3] * v[3]);
                        u32x2 w; w.x = cvt_pk_bf16(v[0], v[1]); w.y = cvt_pk_bf16(v[2], v[3]); *(u32x2*)(nrow + c) = w; }
                sq += __shfl_xor(sq, 16); sq += __shfl_xor(sq, 32);
                if (fq == 0) P[rl * 4 + wc] = sq; }
            asm volatile("" ::: "memory");
        }
        asm volatile("s_waitcnt lgkmcnt(0)" ::: "memory"); __builtin_amdgcn_s_barrier(); asm volatile("" ::: "memory");
        const int t = (wr * 4 + wc) * 64 + fq * 16 + fr;
        if (t < 256) { const f32x4 p = *(const PG8_LAS f32x4*)(P + t * 4); ss[(size_t)u.pn * 49152 + u.pm * BM + t] = (p[0] + p[1]) + (p[2] + p[3]); }
    }
};
__device__ __forceinline__ float dpp_ror1(float v) { return __builtin_bit_cast(float, __builtin_amdgcn_update_dpp(0, __builtin_bit_cast(int, v), 0x121, 0xf, 0xf, false)); }
__device__ __forceinline__ float dpp_ror15(float v) { return __builtin_bit_cast(float, __builtin_amdgcn_update_dpp(0, __builtin_bit_cast(int, v), 0x12F, 0xf, 0xf, false)); }
__device__ __forceinline__ f32x4 ror1_4(f32x4 v) { return (f32x4){dpp_ror1(v[0]), dpp_ror1(v[1]), dpp_ror1(v[2]), dpp_ror1(v[3])}; }
__device__ __forceinline__ f32x4 ror15_4(f32x4 v) { return (f32x4){dpp_ror15(v[0]), dpp_ror15(v[1]), dpp_ror15(v[2]), dpp_ror15(v[3])}; }
__device__ __forceinline__ float silu_f(float s) { return s * __builtin_amdgcn_rcpf(1.0f + __builtin_amdgcn_exp2f(-1.4426950408889634f * s)); }
struct EpiConvGlu {
    static constexpr bool PERM = true, AFTER_DRAIN = false;
    bf16_t* act; const float* wconv; const float* bconv; float* hS; float* hV; float* hG; PG8_LAS float* xch; const float* rstd;
    __device__ __forceinline__ void operator()(f32x4 (&acc)[2][2][4][2], const Unit& u, int wr, int wc, int fr, int fq) const {
        const int cl = wc * 32 + 8 * fq, gc = u.pn * HALF + cl;
        f32x4 w0[2], w1[2], w2[2], bb[2];
#pragma unroll
        for (int n = 0; n < 2; ++n) { w0[n] = *(const f32x4*)(wconv + gc + 4 * n); w1[n] = *(const f32x4*)(wconv + D_FF_C + gc + 4 * n);
            w2[n] = *(const f32x4*)(wconv + 2 * D_FF_C + gc + 4 * n); bb[n] = *(const f32x4*)(bconv + gc + 4 * n); }
        float rs[2][4];
#pragma unroll
        for (int ai = 0; ai < 2; ++ai)
#pragma unroll
            for (int m = 0; m < 4; ++m) rs[ai][m] = rstd[u.pm * BM + ai * HALF + wr * 64 + m * 16 + fr];
#pragma unroll
        for (int ai = 0; ai < 2; ++ai)
#pragma unroll
            for (int m = 0; m < 4; ++m)
#pragma unroll
                for (int bj = 0; bj < 2; ++bj)
#pragma unroll
                    for (int n = 0; n < 2; ++n) acc[ai][bj][m][n] = acc[ai][bj][m][n] * rs[ai][m];
#pragma unroll
        for (int ai = 0; ai < 2; ++ai) { const int blk = 2 * ai + wr;
            if (fr == 0) { *(PG8_LAS f32x4*)(xch + (blk * 2 + 0) * HALF + cl) = acc[ai][0][0][0]; *(PG8_LAS f32x4*)(xch + (blk * 2 + 0) * HALF + cl + 4) = acc[ai][0][0][1]; }
            if (fr == 15) { *(PG8_LAS f32x4*)(xch + (blk * 2 + 1) * HALF + cl) = acc[ai][0][3][0]; *(PG8_LAS f32x4*)(xch + (blk * 2 + 1) * HALF + cl + 4) = acc[ai][0][3][1]; } }
        asm volatile("s_waitcnt lgkmcnt(0)" ::: "memory"); __builtin_amdgcn_s_barrier(); asm volatile("" ::: "memory");
#pragma unroll
        for (int ai = 0; ai < 2; ++ai) { const int blk = 2 * ai + wr;
            f32x4 top[2], bot[2];
#pragma unroll
            for (int n = 0; n < 2; ++n) {
                top[n] = blk > 0 ? *(const PG8_LAS f32x4*)(xch + ((blk - 1) * 2 + 1) * HALF + cl + 4 * n) : (f32x4){0.f, 0.f, 0.f, 0.f};
                bot[n] = blk < 3 ? *(const PG8_LAS f32x4*)(xch + ((blk + 1) * 2 + 0) * HALF + cl + 4 * n) : (f32x4){0.f, 0.f, 0.f, 0.f}; }
#pragma unroll
            for (int m = 0; m < 4; ++m) { const int rl = ai * HALF + wr * 64 + m * 16 + fr; const size_t r = (size_t)u.pm * BM + rl;
                u32x4 w;
#pragma unroll
                for (int n = 0; n < 2; ++n) {
                    const f32x4 g = acc[ai][0][m][n];
                    f32x4 up = ror1_4(g), dn = ror15_4(g);
                    if (m > 0) { const f32x4 pu = ror1_4(acc[ai][0][m > 0 ? m - 1 : 0][n]); if (fr == 0) up = pu; } else { if (fr == 0) up = top[n]; }
                    if (m < 3) { const f32x4 pd = ror15_4(acc[ai][0][m < 3 ? m + 1 : 3][n]); if (fr == 15) dn = pd; } else { if (fr == 15) dn = bot[n]; }
                    const f32x4 s = w0[n] * up + w1[n] * g + w2[n] * dn + bb[n];
                    const f32x4 v = acc[ai][1][m][n];
                    const f32x4 a = (f32x4){silu_f(s[0]) * v[0], silu_f(s[1]) * v[1], silu_f(s[2]) * v[2], silu_f(s[3]) * v[3]};
                    if (n == 0) { w.x = cvt_pk_bf16(a[0], a[1]); w.y = cvt_pk_bf16(a[2], a[3]); } else { w.z = cvt_pk_bf16(a[0], a[1]); w.w = cvt_pk_bf16(a[2], a[3]); }
                    if (rl == 0 || rl == 255) { const size_t ho = ((size_t)u.pm * 2 + (rl ? 1 : 0)) * D_FF_C + gc + 4 * n;
                        *(f32x4*)(hS + ho) = s; *(f32x4*)(hV + ho) = v; *(f32x4*)(hG + ho) = g; }
                }
                *(u32x4*)(act + r * D_FF_C + gc) = w; } }
    }
};
template <class Epi, class Sched, bool ALIGN_EPI = false, bool SP2 = false>
__device__ __forceinline__ void gemm_phase(PG8_LAS unsigned char* lds, const Gemm g, const Sched& S, const Epi& E, const int mk_wave) {
    const int lane = (int)__builtin_amdgcn_mbcnt_hi(~0u, __builtin_amdgcn_mbcnt_lo(~0u, 0u)), wid = mk_wave, tid = wid * 64 + lane, wr = wid >> 2, wc = wid & 3, fr = lane & 15, fq = lane >> 4;
    const int K = g.K, nt = K / BK;
    unsigned voffA[2], voffB[2];
#pragma unroll
    for (int i = 0; i < 2; ++i) { int R, C; stage_rc(tid * 16 + i * 8192, R, C); const int Rb = Epi::PERM ? ((R & ~31) + perm32(R & 31)) : R;
        voffA[i] = (unsigned)(R * K + C) * 2u; voffB[i] = (unsigned)(Rb * K + C) * 2u; }
    const size_t kstep = (size_t)(BK * 2);
    const size_t hstep = (size_t)HALF * K * 2;
    const size_t tstep = 2 * hstep;
    const unsigned ldsw = (unsigned)wid * 1024u;
    const int aoff = lds_byte(wr * 64 + fr, fq * 8), boff = lds_byte(wc * 32 + fr, fq * 8);
#define PG8_SA(b, h) (((b) * 2 + (h)) * HTB)
#define PG8_SB(b, h) ((4 + (b) * 2 + (h)) * HTB)
#define PG8_STAGE(bufoff, gbase, voff) do { _Pragma("unroll") for (int _i = 0; _i < 2; ++_i) \
        __builtin_amdgcn_global_load_lds((const unsigned*)((const char*)(gbase) + (voff)[_i]), (PG8_LAS unsigned*)(lds + (bufoff) + ldsw + _i * 8192), 16, 0, 0); } while (0)
#define PG8_LDA(dst, b, h) do { _Pragma("unroll") for (int m = 0; m < 4; ++m) _Pragma("unroll") for (int k = 0; k < 2; ++k) dst[m][k] = *(const PG8_LAS bf16x8*)(lds + PG8_SA(b, h) + aoff + m * 2048 + k * 1024); } while (0)
#define PG8_LDB(dst, b, h) do { _Pragma("unroll") for (int n = 0; n < 2; ++n) _Pragma("unroll") for (int k = 0; k < 2; ++k) dst[n][k] = *(const PG8_LAS bf16x8*)(lds + PG8_SB(b, h) + boff + n * 2048 + k * 1024); } while (0)
#define PG8_MMA(ai, bj, At, Bt) do { __builtin_amdgcn_s_setprio(1); _Pragma("unroll") for (int m = 0; m < 4; ++m) _Pragma("unroll") for (int n = 0; n < 2; ++n) _Pragma("unroll") for (int k = 0; k < 2; ++k) \
        acc[ai][bj][m][n] = __builtin_amdgcn_mfma_f32_16x16x32_bf16(Bt[n][k], At[m][k], acc[ai][bj][m][n], 0, 0, 0); __builtin_amdgcn_s_setprio(0); } while (0)
#define PG8_WAIT_V(n) asm volatile("s_waitcnt vmcnt(" #n ")" ::: "memory")
#define PG8_WAIT_L(n) asm volatile("s_waitcnt lgkmcnt(" #n ")" ::: "memory")
#define PG8_BAR __builtin_amdgcn_s_barrier()
#define PG8_SCHED __builtin_amdgcn_sched_barrier(0)
    Unit cur, nxt; int ui = 0;
    if (!S.next(0, cur)) return;
    f32x4 acc[2][2][4][2];
#pragma unroll
    for (int a = 0; a < 2; ++a)
#pragma unroll
        for (int b = 0; b < 2; ++b)
#pragma unroll
            for (int m = 0; m < 4; ++m)
#pragma unroll
                for (int n = 0; n < 2; ++n) acc[a][b][m][n] = (f32x4){0.f, 0.f, 0.f, 0.f};
    bf16x8 At[4][2], B0[2][2], B1[2][2];
    const char* cA = (const char*)g.A + (size_t)cur.pm * tstep; const char* cB = (const char*)g.Bt + (size_t)cur.pn * tstep;
    S.a_ready(cur);
    if constexpr (SP2) {
        PG8_STAGE(PG8_SB(0, 0), cB, voffB); PG8_STAGE(PG8_SB(0, 1), cB + hstep, voffB); PG8_STAGE(PG8_SA(0, 0), cA, voffA); PG8_STAGE(PG8_SA(0, 1), cA + hstep, voffA);
        if (wr == 1) PG8_BAR;
        PG8_WAIT_V(2); PG8_BAR;
        PG8_STAGE(PG8_SB(1, 0), cB + kstep, voffB); PG8_STAGE(PG8_SA(1, 0), cA + kstep, voffA); PG8_STAGE(PG8_SB(1, 1), cB + hstep + kstep, voffB);
        PG8_WAIT_V(6); PG8_BAR;
    } else {
        PG8_STAGE(PG8_SB(0, 0), cB, voffB); PG8_STAGE(PG8_SA(0, 0), cA, voffA); PG8_STAGE(PG8_SB(0, 1), cB + hstep, voffB); PG8_STAGE(PG8_SA(0, 1), cA + hstep, voffA);
        if (wr == 1) PG8_BAR;
        PG8_WAIT_V(4); PG8_BAR;
        PG8_STAGE(PG8_SB(1, 0), cB + kstep, voffB); PG8_STAGE(PG8_SA(1, 0), cA + kstep, voffA); PG8_STAGE(PG8_SB(1, 1), cB + hstep + kstep, voffB);
        PG8_WAIT_V(6); PG8_BAR;
    }
    for (;;) {
        const bool has_next = S.next(ui + 1, nxt);
        const char* nA = has_next ? (const char*)g.A + (size_t)nxt.pm * tstep : cA; const char* nB = has_next ? (const char*)g.Bt + (size_t)nxt.pn * tstep : cB;
        for (int t = 0; t < nt; t += 2) {
            const bool last = (t == nt - 2);
            const char* a1 = cA + (size_t)(t + 1) * kstep;
            const char* a2 = last ? nA : cA + (size_t)(t + 2) * kstep; const char* b2 = last ? nB : cB + (size_t)(t + 2) * kstep;
            const char* a3 = a2 + kstep; const char* b3 = b2 + kstep;
            if (last && has_next) S.a_ready(nxt);
            if constexpr (SP2) {
            PG8_LDB(B0, 0, 0); PG8_LDB(B1, 0, 1); PG8_SCHED; PG8_LDA(At, 0, 0); PG8_STAGE(PG8_SA(1, 1), a1 + hstep, voffA);
            PG8_WAIT_V(8); PG8_WAIT_L(0); PG8_BAR; PG8_MMA(0, 0, At, B0); PG8_MMA(0, 1, At, B1); PG8_BAR; PG8_SCHED;
            PG8_LDA(At, 0, 1); PG8_STAGE(PG8_SB(0, 0), b2, voffB); PG8_STAGE(PG8_SB(0, 1), b2 + hstep, voffB); PG8_STAGE(PG8_SA(0, 0), a2, voffA);
            PG8_WAIT_V(8); PG8_WAIT_L(0); PG8_BAR; PG8_MMA(1, 0, At, B0); PG8_MMA(1, 1, At, B1); PG8_BAR; PG8_SCHED;
            PG8_LDB(B0, 1, 0); PG8_LDB(B1, 1, 1); PG8_SCHED; PG8_LDA(At, 1, 0); PG8_STAGE(PG8_SA(0, 1), a2 + hstep, voffA);
            PG8_WAIT_V(8); PG8_WAIT_L(0); PG8_BAR; PG8_MMA(0, 0, At, B0); PG8_MMA(0, 1, At, B1); PG8_BAR; PG8_SCHED;
            PG8_LDA(At, 1, 1); PG8_STAGE(PG8_SB(1, 0), b3, voffB); PG8_STAGE(PG8_SB(1, 1), b3 + hstep, voffB); PG8_STAGE(PG8_SA(1, 0), a3, voffA);
            PG8_WAIT_V(8); PG8_WAIT_L(0); PG8_BAR; PG8_MMA(1, 0, At, B0); PG8_MMA(1, 1, At, B1); PG8_BAR; PG8_SCHED;
            } else {
            PG8_LDB(B0, 0, 0); PG8_SCHED; PG8_LDA(At, 0, 0); PG8_STAGE(PG8_SA(1, 1), a1 + hstep, voffA);
            PG8_WAIT_L(8); PG8_BAR; PG8_WAIT_L(0); PG8_MMA(0, 0, At, B0); PG8_BAR; PG8_SCHED;
            PG8_LDB(B1, 0, 1); PG8_STAGE(PG8_SB(0, 0), b2, voffB);
            PG8_BAR; PG8_WAIT_L(0); PG8_MMA(0, 1, At, B1); PG8_BAR;
            PG8_LDA(At, 0, 1); PG8_STAGE(PG8_SA(0, 0), a2, voffA);
            PG8_BAR; PG8_WAIT_L(0); PG8_MMA(1, 0, At, B0); PG8_BAR; PG8_SCHED;
            PG8_STAGE(PG8_SB(0, 1), b2 + hstep, voffB);
            PG8_WAIT_V(6); PG8_BAR; PG8_MMA(1, 1, At, B1); PG8_BAR;
            PG8_LDB(B0, 1, 0); PG8_SCHED; PG8_LDA(At, 1, 0); PG8_STAGE(PG8_SA(0, 1), a2 + hstep, voffA);
            PG8_WAIT_L(8); PG8_BAR; PG8_WAIT_L(0); PG8_MMA(0, 0, At, B0); PG8_BAR; PG8_SCHED;
            PG8_LDB(B1, 1, 1); PG8_STAGE(PG8_SB(1, 0), b3, voffB);
            PG8_BAR; PG8_WAIT_L(0); PG8_MMA(0, 1, At, B1); PG8_BAR;
            PG8_LDA(At, 1, 1); PG8_STAGE(PG8_SA(1, 0), a3, voffA);
            PG8_BAR; PG8_WAIT_L(0); PG8_MMA(1, 0, At, B0); PG8_BAR; PG8_SCHED;
            PG8_STAGE(PG8_SB(1, 1), b3 + hstep, voffB);
            PG8_WAIT_V(6); PG8_BAR; PG8_MMA(1, 1, At, B1); PG8_BAR;
            }
        }
        if constexpr (ALIGN_EPI) { if (wr == 0) PG8_BAR; }
        if constexpr (!Epi::AFTER_DRAIN) { E(acc, cur, wr, wc, fr, fq); S.done(cur); }
        if (!has_next) break;
#pragma unroll
        for (int a = 0; a < 2; ++a)
#pragma unroll
            for (int b = 0; b < 2; ++b)
#pragma unroll
                for (int m = 0; m < 4; ++m)
#pragma unroll
                    for (int n = 0; n < 2; ++n) acc[a][b][m][n] = (f32x4){0.f, 0.f, 0.f, 0.f};
        cur = nxt; cA = nA; cB = nB; ++ui;
        if constexpr (ALIGN_EPI) { if (wr == 1) PG8_BAR; }
    }
    PG8_WAIT_V(0);
    if constexpr (!ALIGN_EPI) { if (wr == 0) PG8_BAR; }
    PG8_BAR;
    if constexpr (Epi::AFTER_DRAIN) { E.fused(acc, cur, wr, wc, fr, fq, lds, wid, lane); S.done(cur); }
#undef PG8_SA
#undef PG8_SB
#undef PG8_STAGE
#undef PG8_LDA
#undef PG8_LDB
#undef PG8_MMA
#undef PG8_WAIT_V
#undef PG8_WAIT_L
#undef PG8_BAR
#undef PG8_SCHED
}
}
namespace att {
using bf16 = __hip_bfloat16;
constexpr int   D = 128, NW = 8, QBLK = 32, KVBLK = 64;
constexpr float SCALE = 0.088388347648318440f;
constexpr float THR = 8.f;
constexpr int SDEPTH = 2;
constexpr int LDQ = 2560, LDK = 2560, LDO = 2048;
constexpr size_t SHM_V = KVBLK * D * 2, SHM_K = KVBLK * D * 2, SHM_ATTN = 2 * SHM_V + 2 * SHM_K + NW * 64 * 4;
using bf16x8 = __attribute__((ext_vector_type(8))) short;
using s16x4  = __attribute__((ext_vector_type(4))) short;
using f32x16 = __attribute__((ext_vector_type(16))) float;
using f32x8  = __attribute__((ext_vector_type(8))) float;
using u32x4  = __attribute__((ext_vector_type(4))) unsigned;
#define KSWZ(row, colB) ((row) * 256 + ((colB) ^ (((row) & 7) << 4)))
#define SBAR() __builtin_amdgcn_sched_barrier(0)
__device__ __forceinline__ int crow(int r, int hi) { return (r & 3) + 8 * (r >> 2) + 4 * hi; }
__device__ __forceinline__ unsigned cvtpk(float lo, float hi) {
  unsigned r; asm volatile("v_cvt_pk_bf16_f32 %0, %1, %2" : "=v"(r) : "v"(lo), "v"(hi)); return r;
}
template <typename TIn> struct Stage;
template <> struct Stage<bf16>  { using T = bf16x8;
  __device__ static __forceinline__ T ld8(const bf16* p) { return *reinterpret_cast<const bf16x8*>(p); }
  __device__ static __forceinline__ bf16x8 tobf(T x) { return x; } };
template <> struct Stage<float> { using T = f32x8;
  __device__ static __forceinline__ T ld8(const float* p) { return *reinterpret_cast<const f32x8*>(p); }
  __device__ static __forceinline__ bf16x8 tobf(T x) {
    u32x4 w = {cvtpk(x[0], x[1]), cvtpk(x[2], x[3]), cvtpk(x[4], x[5]), cvtpk(x[6], x[7])}; return *reinterpret_cast<bf16x8*>(&w); } };

__device__ __forceinline__ void partialSM(f32x16& p0, f32x16& p1, float& m_reg, float& mn, float& alpha) {
  constexpr float C = SCALE * 1.4426950408889634f;
  float pmax = p0[0]; for (int r = 1; r < 16; ++r) pmax = fmaxf(pmax, p0[r]); for (int r = 0; r < 16; ++r) pmax = fmaxf(pmax, p1[r]);
  { auto rr = __builtin_amdgcn_permlane32_swap(__float_as_uint(pmax), __float_as_uint(pmax), false, false);
    pmax = fmaxf(__uint_as_float(rr[0]), __uint_as_float(rr[1])); }
  if (__builtin_expect(__all(pmax - m_reg <= THR / SCALE), 1)) { mn = m_reg; alpha = 1.f; }
  else { mn = fmaxf(m_reg, pmax); alpha = __builtin_amdgcn_exp2f((m_reg - mn) * C); m_reg = mn; }
  float mnC = -mn * C;
  for (int r = 0; r < 16; ++r) p0[r] = fmaf(p0[r], C, mnC); for (int r = 0; r < 16; ++r) p1[r] = fmaf(p1[r], C, mnC);
  for (int r = 0; r < 16; ++r) p0[r] = __builtin_amdgcn_exp2f(p0[r]);
}
__device__ __forceinline__ void finishSM(f32x16& p0, f32x16& p1, float alpha, float& l_reg, bf16x8& pa0, bf16x8& pa1, bf16x8& pa2, bf16x8& pa3) {
  for (int r = 0; r < 16; ++r) p1[r] = __builtin_amdgcn_exp2f(p1[r]);
  float ps = 0; for (int r = 0; r < 16; ++r) ps += p0[r]; for (int r = 0; r < 16; ++r) ps += p1[r];
  { auto rr = __builtin_amdgcn_permlane32_swap(__float_as_uint(ps), __float_as_uint(ps), false, false);
    ps = __uint_as_float(rr[0]) + __uint_as_float(rr[1]); }
  l_reg = l_reg * alpha + ps;
#define PK4(P, BASE, OUT) do { unsigned a0 = cvtpk(P[BASE + 0], P[BASE + 1]), a1 = cvtpk(P[BASE + 2], P[BASE + 3]);   \
    unsigned b0 = cvtpk(P[BASE + 4], P[BASE + 5]), b1 = cvtpk(P[BASE + 6], P[BASE + 7]);                              \
    auto r0 = __builtin_amdgcn_permlane32_swap(a0, b0, false, false); auto r1 = __builtin_amdgcn_permlane32_swap(a1, b1, false, false); \
    u32x4 w = {r0[0], r1[0], r0[1], r1[1]}; OUT = *reinterpret_cast<bf16x8*>(&w); } while (0)
  PK4(p0, 0, pa0); PK4(p0, 8, pa1); PK4(p1, 0, pa2); PK4(p1, 8, pa3);
#undef PK4
}
__device__ __forceinline__ void partialSM2(f32x16& p0, f32x16& p1, float mnC) {
  constexpr float C = SCALE * 1.4426950408889634f;
  for (int r = 0; r < 16; ++r) p0[r] = fmaf(p0[r], C, mnC); for (int r = 0; r < 16; ++r) p1[r] = fmaf(p1[r], C, mnC);
  for (int r = 0; r < 16; ++r) p0[r] = __builtin_amdgcn_exp2f(p0[r]);
}
__device__ __forceinline__ void finishSM2(f32x16& p0, f32x16& p1, float& l_reg, bf16x8& pa0, bf16x8& pa1, bf16x8& pa2, bf16x8& pa3) {
  for (int r = 0; r < 16; ++r) p1[r] = __builtin_amdgcn_exp2f(p1[r]);
  float ps = 0; for (int r = 0; r < 16; ++r) ps += p0[r]; for (int r = 0; r < 16; ++r) ps += p1[r];
  { auto rr = __builtin_amdgcn_permlane32_swap(__float_as_uint(ps), __float_as_uint(ps), false, false);
    ps = __uint_as_float(rr[0]) + __uint_as_float(rr[1]); }
  l_reg += ps;
#define PK4(P, BASE, OUT) do { unsigned a0 = cvtpk(P[BASE + 0], P[BASE + 1]), a1 = cvtpk(P[BASE + 2], P[BASE + 3]);   \
    unsigned b0 = cvtpk(P[BASE + 4], P[BASE + 5]), b1 = cvtpk(P[BASE + 6], P[BASE + 7]);                              \
    auto r0 = __builtin_amdgcn_permlane32_swap(a0, b0, false, false); auto r1 = __builtin_amdgcn_permlane32_swap(a1, b1, false, false); \
    u32x4 w = {r0[0], r1[0], r0[1], r1[1]}; OUT = *reinterpret_cast<bf16x8*>(&w); } while (0)
  PK4(p0, 0, pa0); PK4(p0, 8, pa1); PK4(p1, 0, pa2); PK4(p1, 8, pa3);
#undef PK4
}
__device__ __forceinline__ void qkt(f32x16& p0, f32x16& p1, const bf16* Ks, const bf16x8* qr, int r32, int hi) {
  p0 = f32x16{}; p1 = f32x16{};
  for (int d0 = 0; d0 < 8; ++d0) { int cb = (d0 * 16 + hi * 8) * 2;
    bf16x8 b0 = *reinterpret_cast<const bf16x8*>((const char*)Ks + KSWZ(r32, cb));
    bf16x8 b1 = *reinterpret_cast<const bf16x8*>((const char*)Ks + KSWZ(32 + r32, cb));
    p0 = __builtin_amdgcn_mfma_f32_32x32x16_bf16(b0, qr[d0], p0, 0, 0, 0);
    p1 = __builtin_amdgcn_mfma_f32_32x32x16_bf16(b1, qr[d0], p1, 0, 0, 0); }
}
__device__ __forceinline__ int v_st(int k, int c) { const int kk = (k & ~0xC) | ((k & 4) << 1) | ((k & 8) >> 1); return ((kk >> 3) * 4 + (c >> 5)) * 512 + ((kk & 7) * 32 + (c & 31)) * 2; }
__device__ __forceinline__ int v_rd_base(int lane) { return ((lane & 3) << 3) | (((lane >> 2) & 3) << 6) | (((lane >> 4) & 1) << 5) | (((lane >> 5) & 1) << 8); }
constexpr int v_rd_off(int d0, int ks, int half) { return d0 * 512 + ks * 4096 + half * 2048; }
template <int OFF> __device__ __forceinline__ s16x4 tr_read(int vb) {
  s16x4 r; asm volatile("ds_read_b64_tr_b16 %0, %1 offset:%2" : "=&v"(r) : "v"(vb), "i"(OFF) : "memory"); return r;
}
template <int D0> __device__ __forceinline__ void pv_one(f32x16& od, int vb, bf16x8 pa0, bf16x8 pa1, bf16x8 pa2, bf16x8 pa3) {
  const s16x4 l0 = tr_read<v_rd_off(D0, 0, 0)>(vb), h0 = tr_read<v_rd_off(D0, 0, 1)>(vb), l1 = tr_read<v_rd_off(D0, 1, 0)>(vb), h1 = tr_read<v_rd_off(D0, 1, 1)>(vb);
  const s16x4 l2 = tr_read<v_rd_off(D0, 2, 0)>(vb), h2 = tr_read<v_rd_off(D0, 2, 1)>(vb), l3 = tr_read<v_rd_off(D0, 3, 0)>(vb), h3 = tr_read<v_rd_off(D0, 3, 1)>(vb);
  asm volatile("s_waitcnt lgkmcnt(0)" ::: "memory"); SBAR();
#define PK(L, H) (bf16x8){L[0], L[1], L[2], L[3], H[0], H[1], H[2], H[3]}
  od = __builtin_amdgcn_mfma_f32_32x32x16_bf16(pa0, PK(l0, h0), od, 0, 0, 0);
  od = __builtin_amdgcn_mfma_f32_32x32x16_bf16(pa1, PK(l1, h1), od, 0, 0, 0);
  od = __builtin_amdgcn_mfma_f32_32x32x16_bf16(pa2, PK(l2, h2), od, 0, 0, 0);
  od = __builtin_amdgcn_mfma_f32_32x32x16_bf16(pa3, PK(l3, h3), od, 0, 0, 0);
#undef PK
}
__device__ __forceinline__ void pv_d0(f32x16* o, int vb, bf16x8 pa0, bf16x8 pa1, bf16x8 pa2, bf16x8 pa3) {
  pv_one<0>(o[0], vb, pa0, pa1, pa2, pa3); pv_one<1>(o[1], vb, pa0, pa1, pa2, pa3); pv_one<2>(o[2], vb, pa0, pa1, pa2, pa3); pv_one<3>(o[3], vb, pa0, pa1, pa2, pa3);
}
template <typename TQ>
__device__ __forceinline__ void attn_dense_body(const TQ* __restrict__ Qb, const bf16* __restrict__ Kh, const bf16* __restrict__ Vh,
                                                unsigned* __restrict__ Ob, int seq, char* lds, const float* __restrict__ gq, int tq0, const float* __restrict__ gk, const int mk_wave) {
  using St = Stage<bf16>; using SQ = Stage<TQ>;
  const int lane = (int)__builtin_amdgcn_mbcnt_hi(~0u, __builtin_amdgcn_mbcnt_lo(~0u, 0u)), wid = mk_wave, tid = wid * 64 + lane, r32 = lane & 31, hi = lane >> 5;
  bf16* V_lds = (bf16*)lds; bf16* K_lds = (bf16*)(lds + 2 * SHM_V);
  float* ws = (float*)(lds + 2 * SHM_V + 2 * SHM_K) + wid * 64; float* li_l = ws; float* al_l = ws + 32;
  float l_reg = 0; f32x16 o[4] = {}; bf16x8 qr[8];
  float mnC;
  { float a = fmaxf(fabsf(gq[lane]), fabsf(gq[lane + 64])), b = fmaxf(fabsf(gk[lane]), fabsf(gk[lane + 64]));
#pragma unroll
    for (int o_ = 1; o_ < 64; o_ <<= 1) { a = fmaxf(a, __shfl_xor(a, o_)); b = fmaxf(b, __shfl_xor(b, o_)); }
    mnC = -(128.0f * a * b) * (SCALE * 1.4426950408889634f); }
  const TQ* Qw = Qb + (long)(wid * QBLK + r32) * LDQ + hi * 8;
#pragma unroll
  for (int d0 = 0; d0 < 8; ++d0) qr[d0] = SQ::tobf(SQ::ld8(Qw + d0 * 16));
  {
    float ss = 0.f;
#pragma unroll
    for (int d0 = 0; d0 < 8; ++d0)
#pragma unroll
      for (int j = 0; j < 8; ++j) { const float x = __uint_as_float(((unsigned)(unsigned short)qr[d0][j]) << 16); ss += x * x; }
    ss += __shfl_xor(ss, 32);
    const float rstd = 1.0f / sqrtf(ss * (1.f / 128.f) + 1e-6f);
    const int tq = tq0 + wid * QBLK + r32;
    int hio = hi * 8; asm volatile("" : "+v"(hio));
#pragma unroll
    for (int ax = 0; ax < 2; ++ax) { const float pos = (float)(ax == 0 ? (tq >> 6) : (tq & 63));
#pragma unroll
      for (int dd = 0; dd < 2; ++dd) { const int da = ax * 4 + dd, db = da + 2;
        const f32x8 ga = *reinterpret_cast<const f32x8*>(gq + da * 16 + hi * 8), gb = *reinterpret_cast<const f32x8*>(gq + db * 16 + hi * 8);
        float oa[8], ob[8];
#pragma unroll
        for (int j = 0; j < 8; ++j) { const float rev = pos * (__builtin_amdgcn_exp2f(-(float)(dd * 16 + hio + j) * 0.41524101186092029f) * 0.15915494309189535f);
          const float cs = __builtin_amdgcn_cosf(rev), sn = __builtin_amdgcn_sinf(rev);
          const float x1 = __uint_as_float(((unsigned)(unsigned short)qr[da][j]) << 16) * rstd * ga[j], x2 = __uint_as_float(((unsigned)(unsigned short)qr[db][j]) << 16) * rstd * gb[j];
          oa[j] = x1 * cs - x2 * sn; ob[j] = x2 * cs + x1 * sn; }
        u32x4 wa = {cvtpk(oa[0], oa[1]), cvtpk(oa[2], oa[3]), cvtpk(oa[4], oa[5]), cvtpk(oa[6], oa[7])}, wb = {cvtpk(ob[0], ob[1]), cvtpk(ob[2], ob[3]), cvtpk(ob[4], ob[5]), cvtpk(ob[6], ob[7])};
        qr[da] = *reinterpret_cast<bf16x8*>(&wa); qr[db] = *reinterpret_cast<bf16x8*>(&wb);
        asm volatile("" : "+v"(qr[da]), "+v"(qr[db])); } }
  }
  const int sr = tid >> 4, sc = (tid & 15) * 8, vst0 = v_st(sr, sc), vst1 = v_st(32 + sr, sc);
  const int vb0 = (int)(uintptr_t)V_lds + v_rd_base(lane);
  struct { typename St::T vs0, vs1, ks0, ks1; } sr_[SDEPTH];
#define SLOAD(i, k0) do { sr_[i].vs0 = St::ld8(&Vh[(long)((k0) + sr) * LDK + sc]); sr_[i].vs1 = St::ld8(&Vh[(long)((k0) + 32 + sr) * LDK + sc]); \
    sr_[i].ks0 = St::ld8(&Kh[(long)((k0) + sr) * LDK + sc]); sr_[i].ks1 = St::ld8(&Kh[(long)((k0) + 32 + sr) * LDK + sc]); } while (0)
#define SWRITE(b, i) do { *(bf16x8*)((char*)V_lds + (b) * SHM_V + vst0) = St::tobf(sr_[i].vs0);          \
    *(bf16x8*)((char*)V_lds + (b) * SHM_V + vst1) = St::tobf(sr_[i].vs1); int kc = sc * 2;               \
    *(bf16x8*)((char*)K_lds + (b) * SHM_K + KSWZ(sr, kc)) = St::tobf(sr_[i].ks0);                       \
    *(bf16x8*)((char*)K_lds + (b) * SHM_K + KSWZ(32 + sr, kc)) = St::tobf(sr_[i].ks1); } while (0)
#define SWAIT() do { if constexpr (SDEPTH == 2) asm volatile("s_waitcnt vmcnt(4)" ::: "memory"); else asm volatile("s_waitcnt vmcnt(0)" ::: "memory"); } while (0)
#define RESC(a) do { if (__any((a) < 1.f)) { if (hi == 0) al_l[r32] = (a); asm volatile("s_waitcnt lgkmcnt(0)" ::: "memory"); \
    for (int d = 0; d < 4; ++d) for (int r = 0; r < 16; ++r) o[d][r] *= al_l[crow(r, hi)]; } } while (0)
  f32x16 pA0, pA1, pB0, pB1; float mnA, mnB, alA, alB; bf16x8 pa0, pa1, pa2, pa3; const int NT = seq / KVBLK;
  constexpr int SE = 0, SO = SDEPTH - 1;
  SLOAD(SE, 0); asm volatile("s_waitcnt vmcnt(0)" ::: "memory"); SWRITE(0, SE); __syncthreads();
  qkt(pA0, pA1, K_lds, qr, r32, hi); partialSM2(pA0, pA1, mnC);
  SLOAD(SO, KVBLK); if constexpr (SDEPTH == 2) { if (2 < NT) SLOAD(SE, 2 * KVBLK); }
  SWAIT(); SWRITE(1, SO); __syncthreads();
  for (int j = 1; j + 1 < NT; j += 2) {
    SBAR(); qkt(pB0, pB1, (bf16*)((char*)K_lds + SHM_K), qr, r32, hi);
    finishSM2(pA0, pA1, l_reg, pa0, pa1, pa2, pa3); SBAR();
    SLOAD(SO, (j + SDEPTH) * KVBLK); SBAR();
    pv_d0(o, vb0, pa0, pa1, pa2, pa3); partialSM2(pB0, pB1, mnC);
    __syncthreads(); SWAIT(); SWRITE(0, SE);
    __syncthreads();
    SBAR(); qkt(pA0, pA1, K_lds, qr, r32, hi);
    finishSM2(pB0, pB1, l_reg, pa0, pa1, pa2, pa3); SBAR();
    if (SDEPTH == 1 || j + 3 < NT) SLOAD(SE, (j + 1 + SDEPTH) * KVBLK); SBAR();
    pv_d0(o, vb0 + (int)SHM_V, pa0, pa1, pa2, pa3); partialSM2(pA0, pA1, mnC);
    __syncthreads(); SWAIT(); SWRITE(1, SO);
    __syncthreads();
  }
  SBAR(); qkt(pB0, pB1, (bf16*)((char*)K_lds + SHM_K), qr, r32, hi);
  finishSM2(pA0, pA1, l_reg, pa0, pa1, pa2, pa3); SBAR();
  pv_d0(o, vb0, pa0, pa1, pa2, pa3); partialSM2(pB0, pB1, mnC);
  __syncthreads();
  finishSM2(pB0, pB1, l_reg, pa0, pa1, pa2, pa3); SBAR();
  pv_d0(o, vb0 + (int)SHM_V, pa0, pa1, pa2, pa3);
  int lane_e = lane; asm volatile("" : "+v"(lane_e));
  const int r32e = lane_e & 31, hie = lane_e >> 5;
  if (hie == 0) li_l[r32e] = l_reg; asm volatile("s_waitcnt lgkmcnt(0)" ::: "memory");
  float rli[16];
#pragma unroll
  for (int r = 0; r < 16; ++r) rli[r] = __builtin_amdgcn_rcpf(li_l[crow(r, hie)]);
  unsigned* Ow = Ob + (long)(wid * QBLK) * (LDO / 2);
#pragma unroll
  for (int r = 0; r < 16; r += 2) {
#pragma unroll
    for (int d0 = 0; d0 < 4; ++d0) {
      const float x = o[d0][r] * rli[r], y = o[d0][r + 1] * rli[r + 1];
      const float snd = (lane_e & 1) ? x : y; const float rcv = __shfl_xor(snd, 1);
      const unsigned w = (lane_e & 1) ? cvtpk(rcv, y) : cvtpk(x, rcv);
      const int orow = crow((lane_e & 1) ? r + 1 : r, hie);
      Ow[(long)orow * (LDO / 2) + ((d0 * 32 + (r32e & ~1)) >> 1)] = w; } }
  __syncthreads();
#undef SLOAD
#undef SWRITE
#undef SWAIT
#undef RESC
}
}

#ifndef MK_PER_PHASE
#define MK_PER_PHASE 0
#endif
#define LAS __attribute__((address_space(3)))
typedef unsigned short bf16r;
typedef float f32x4g __attribute__((ext_vector_type(4)));
typedef unsigned u32x4g __attribute__((ext_vector_type(4)));
typedef unsigned u32x2g __attribute__((ext_vector_type(2)));
constexpr size_t MiB = 1u << 20;
constexpr size_t WS_WIN = 2 * MiB, WS_WPOOL = 12 * MiB, WS_WOUT = 13 * MiB, WS_WUP = 21 * MiB, WS_WDOWN = 65 * MiB;
constexpr size_t WS_XN = 96 * MiB;
constexpr size_t WS_Z = 288 * MiB;
constexpr size_t WS_D = 528 * MiB;
constexpr size_t WS_AM = 624 * MiB;
constexpr size_t WS_ACT = 288 * MiB;
constexpr size_t WS_HS = 816 * MiB, WS_HV = 825 * MiB, WS_HG = 834 * MiB, WS_SS = 843 * MiB, WS_RSTD = 845 * MiB, WS_END = 846 * MiB;
static_assert(WS_WDOWN + (size_t)2048 * 5632 * 2 <= WS_XN && WS_XN + (size_t)M_ALL * 2048 * 2 <= WS_Z && WS_Z + (size_t)M_ALL * 2560 * 2 <= WS_D && WS_D + (size_t)M_ALL * 1024 * 2 <= WS_AM &&
              WS_AM + (size_t)M_ALL * 2048 * 2 <= WS_HS && WS_ACT + (size_t)M_ALL * 5632 * 2 <= WS_HS && WS_HS + (size_t)192 * 2 * 5632 * 4 <= WS_HV, "d_ws map");
constexpr int RING_BYTES = 131072, XCH_OFF = RING_BYTES, XBST_OFF = RING_BYTES + 12288, LDS_BYTES = 147456;
constexpr size_t WS_BAR = 0;
constexpr int N_PHASES = 9;

__device__ __forceinline__ float wave_sum(float v) {
#pragma unroll
    for (int o = 1; o < 64; o <<= 1) v += __shfl_xor(v, o);
    return v;
}
__device__ __forceinline__ float bf_lo(unsigned w) { return __uint_as_float(w << 16); }
__device__ __forceinline__ float bf_hi(unsigned w) { return __uint_as_float(w & 0xffff0000u); }
#define LDS_WAIT() asm volatile("s_waitcnt lgkmcnt(0)" ::: "memory")

template <int MODE> __device__ __forceinline__ void transpose_item(const float* W, int K, int N, bf16r* WT, int row_off, LAS float* scr, int item, int lane, const float* kscale = nullptr) {
    const int nblk = N / 32, kb = item / nblk, nb = item % nblk, k0 = 64 * kb, n0 = 32 * nb;
    float tv[32];
#pragma unroll
    for (int i = 0; i < 32; ++i) { const int kk = 2 * i + (lane >> 5); tv[i] = W[(size_t)(k0 + kk) * N + n0 + (lane & 31)]; }
    if (MODE == 1) {
        float ks[32];
#pragma unroll
        for (int i = 0; i < 32; ++i) ks[i] = kscale[k0 + 2 * i + (lane >> 5)];
#pragma unroll
        for (int i = 0; i < 32; ++i) tv[i] *= ks[i];
    }
#pragma unroll
    for (int i = 0; i < 32; ++i) { const int kk = 2 * i + (lane >> 5); scr[kk * 33 + (lane & 31)] = tv[i]; }
    LDS_WAIT(); asm volatile("" ::: "memory");
    int d0 = row_off + n0;
    if (MODE == 1) d0 = n0 < 5632 ? 256 * (n0 / 128) + (n0 % 128) : 256 * ((n0 - 5632) / 128) + 128 + ((n0 - 5632) % 128);
    const int c = lane & 7;
#pragma unroll
    for (int j = 0; j < 4; ++j) { const int n = (lane >> 3) + 8 * j; const LAS float* s = scr + (8 * c) * 33 + n;
        u32x4g o; o.x = pg8::cvt_pk_bf16(s[0 * 33], s[1 * 33]); o.y = pg8::cvt_pk_bf16(s[2 * 33], s[3 * 33]); o.z = pg8::cvt_pk_bf16(s[4 * 33], s[5 * 33]); o.w = pg8::cvt_pk_bf16(s[6 * 33], s[7 * 33]);
        *(u32x4g*)(WT + (size_t)(d0 + n) * K + k0 + 8 * c) = o; }
    LDS_WAIT(); asm volatile("" ::: "memory");
}
__device__ __forceinline__ void rms_rows_to_bf16(const float* x_p, const float* x_s, const float* g, bf16r* xn, int gw, int NGW, int lane) {
    f32x4g gv[8], cur[8], nxt[8];
    const f32x4g* gr = (const f32x4g*)g + lane;
#pragma unroll
    for (int j = 0; j < 8; ++j) gv[j] = gr[64 * j];
    int m = gw;
    if (m < M_ALL) { const f32x4g* xr = (const f32x4g*)(m < M_P ? x_p + (size_t)m * 2048 : x_s + (size_t)(m - M_P) * 2048) + lane;
#pragma unroll
        for (int j = 0; j < 8; ++j) cur[j] = __builtin_nontemporal_load(&xr[64 * j]); }
    for (; m < M_ALL; m += NGW) {
        const int mn = m + NGW;
        if (mn < M_ALL) { const f32x4g* xr = (const f32x4g*)(mn < M_P ? x_p + (size_t)mn * 2048 : x_s + (size_t)(mn - M_P) * 2048) + lane;
#pragma unroll
            for (int j = 0; j < 8; ++j) nxt[j] = __builtin_nontemporal_load(&xr[64 * j]); }
        float s = 0.f;
#pragma unroll
        for (int j = 0; j < 8; ++j) s += (cur[j].x * cur[j].x + cur[j].y * cur[j].y) + (cur[j].z * cur[j].z + cur[j].w * cur[j].w);
        const float rstd = 1.0f / sqrtf(wave_sum(s) * (1.f / 2048.f) + RMS_EPS);
        u32x2g* o8 = (u32x2g*)(xn + (size_t)m * 2048) + lane;
#pragma unroll
        for (int j = 0; j < 8; ++j) { const f32x4g y = cur[j] * rstd * gv[j]; u32x2g w; w.x = pg8::cvt_pk_bf16(y.x, y.y); w.y = pg8::cvt_pk_bf16(y.z, y.w); o8[64 * j] = w; }
#pragma unroll
        for (int j = 0; j < 8; ++j) cur[j] = nxt[j];
    }
}
template <int HW> __device__ __forceinline__ void pool_item(const bf16r* vcol  , int t0, int L, const float* sc8, bf16r* ocol  ) {
    constexpr int RB = 8, NR = 2 * HW + RB - 1;
    u32x4g rows[NR];
#pragma unroll
    for (int j = 0; j < NR; ++j) { const int t = t0 - HW + j; rows[j] = (t >= 0 && t < L) ? *(const u32x4g*)(vcol + (size_t)t * N_IN) : (u32x4g){0u, 0u, 0u, 0u}; }
    const f32x4g sa = *(const f32x4g*)sc8, sb = *(const f32x4g*)(sc8 + 4);
    float S[8] = {0.f, 0.f, 0.f, 0.f, 0.f, 0.f, 0.f, 0.f};
#define POOL_ACC(R, SGN) do { S[0] += SGN bf_lo(R.x); S[1] += SGN bf_hi(R.x); S[2] += SGN bf_lo(R.y); S[3] += SGN bf_hi(R.y); S[4] += SGN bf_lo(R.z); S[5] += SGN bf_hi(R.z); S[6] += SGN bf_lo(R.w); S[7] += SGN bf_hi(R.w); } while (0)
#pragma unroll
    for (int j = 0; j < 2 * HW; ++j) POOL_ACC(rows[j], +);
#pragma unroll
    for (int i = 0; i < RB; ++i) { const int t = t0 + i; const int lo = t - HW < 0 ? 0 : t - HW, hi = t + HW > L ? L : t + HW; const float rc = 1.0f / (float)(hi - lo);
        const u32x4g U = rows[i + HW];
        u32x4g O; O.x = pg8::cvt_pk_bf16((S[0] * rc - bf_lo(U.x)) * sa.x, (S[1] * rc - bf_hi(U.x)) * sa.y); O.y = pg8::cvt_pk_bf16((S[2] * rc - bf_lo(U.y)) * sa.z, (S[3] * rc - bf_hi(U.y)) * sa.w);
        O.z = pg8::cvt_pk_bf16((S[4] * rc - bf_lo(U.z)) * sb.x, (S[5] * rc - bf_hi(U.z)) * sb.y); O.w = pg8::cvt_pk_bf16((S[6] * rc - bf_lo(U.w)) * sb.z, (S[7] * rc - bf_hi(U.w)) * sb.w);
        *(u32x4g*)(ocol + (size_t)i * 2048) = O;
        if (i < RB - 1) { POOL_ACC(rows[i + 2 * HW], +); POOL_ACC(rows[i], -); } }
#undef POOL_ACC
}
__device__ __forceinline__ void fold_pool_item(const float* w_in, const float* w_pool, bf16r* WT, LAS float* scr, int item, int lane) {
    const int g = item >> 9, kb = (item >> 2) & 127, db = item & 3, k0 = kb * 16, d0 = db * 64;
    f32x4g av[16];
#pragma unroll
    for (int kk = 0; kk < 16; ++kk) av[kk] = *(const f32x4g*)(w_in + (size_t)(k0 + kk) * N_IN + 1536 + g * 256 + lane * 4);
#pragma unroll
    for (int kk = 0; kk < 16; ++kk) *(LAS f32x4g*)(scr + kk * 256 + lane * 4) = av[kk];
    LDS_WAIT(); asm volatile("" ::: "memory");
    const float* bp = w_pool + (size_t)g * 65536 + d0 + lane;
    float acc[16];
#pragma unroll
    for (int kk = 0; kk < 16; ++kk) acc[kk] = 0.f;
#pragma unroll 2
    for (int c = 0; c < 256; c += 4) {
        const float b0 = bp[(size_t)(c + 0) * 256], b1 = bp[(size_t)(c + 1) * 256], b2 = bp[(size_t)(c + 2) * 256], b3 = bp[(size_t)(c + 3) * 256];
#pragma unroll
        for (int kk = 0; kk < 16; ++kk) { const f32x4g a = *(const LAS f32x4g*)(scr + kk * 256 + c); acc[kk] += a.x * b0 + a.y * b1 + a.z * b2 + a.w * b3; }
    }
    u32x4g o0, o1;
    o0.x = pg8::cvt_pk_bf16(acc[0], acc[1]); o0.y = pg8::cvt_pk_bf16(acc[2], acc[3]); o0.z = pg8::cvt_pk_bf16(acc[4], acc[5]); o0.w = pg8::cvt_pk_bf16(acc[6], acc[7]);
    o1.x = pg8::cvt_pk_bf16(acc[8], acc[9]); o1.y = pg8::cvt_pk_bf16(acc[10], acc[11]); o1.z = pg8::cvt_pk_bf16(acc[12], acc[13]); o1.w = pg8::cvt_pk_bf16(acc[14], acc[15]);
    bf16r* orow = WT + (size_t)(1536 + g * 256 + d0 + lane) * 2048 + k0;
    *(u32x4g*)orow = o0; *(u32x4g*)(orow + 8) = o1;
    LDS_WAIT(); asm volatile("" ::: "memory");
}
#define XB_TMO      128
#define XB_XCNT(j)  (256  + 64 * (j))
#define XB_XSUB(j)  (1280 + 64 * (j))
#define XB_XGEN(j)  (2304 + 64 * (j))
#define XB_TOP      3328
#define XB_TOPGEN   3392
#define XCD_BAR_WORDS 3456
#define XB_SPIN_CAP (1u << 18)

__device__ __forceinline__ unsigned xb_ld(unsigned* p)              { return __hip_atomic_load(p, __ATOMIC_RELAXED, __HIP_MEMORY_SCOPE_AGENT); }
__device__ __forceinline__ unsigned xb_add(unsigned* p, unsigned v) { return __hip_atomic_fetch_add(p, v, __ATOMIC_RELAXED, __HIP_MEMORY_SCOPE_AGENT); }
__device__ __forceinline__ unsigned xb_xcc_id() { return (unsigned)__builtin_amdgcn_s_getreg((3 << 11) | 20) & 0xFu; }
#define XB_SPIN(cond, bar) do { unsigned _sp = 0; while (cond) { __builtin_amdgcn_s_sleep(1); \
    if ((++_sp & 255u) == 0u) { if (xb_ld(&(bar)[XB_TMO])) break; if (_sp > XB_SPIN_CAP) { atomicAdd(&(bar)[XB_TMO], 1u); break; } } } } while (0)

struct XcdBarrier {
    unsigned* bar; unsigned x;
    volatile __attribute__((address_space(3))) unsigned* st;
};

__device__ __forceinline__ XcdBarrier xcd_barrier_post(unsigned* bar, volatile __attribute__((address_space(3))) unsigned* st, bool leader) {
    XcdBarrier b; b.bar = bar; b.x = xb_xcc_id(); b.st = st;
    if (leader) (void)xb_add(&bar[XB_XCNT(b.x)], 1u);
    return b;
}
__device__ __forceinline__ void xcd_barrier_complete(unsigned* bar, unsigned x, unsigned& nloc, unsigned& nx) {
    const unsigned G = gridDim.x * gridDim.y * gridDim.z;
    unsigned sum, cnt, mine, sp = 0u;
    for (;;) {
        sum = 0u; cnt = 0u; mine = 0u;
#pragma unroll
        for (unsigned j = 0; j < 16; ++j) { const unsigned c = xb_ld(&bar[XB_XCNT(j)]); sum += c; cnt += (c > 0u) ? 1u : 0u; mine = (j == x) ? c : mine; }
        if (sum == G) break;
        __builtin_amdgcn_s_sleep(1);
        if ((++sp & 255u) == 0u) { if (xb_ld(&bar[XB_TMO])) break; if (sp > XB_SPIN_CAP) { atomicAdd(&bar[XB_TMO], 1u); break; } }
    }
    nloc = mine > 0u ? mine : 1u; nx = cnt > 0u ? cnt : 1u;
}

__device__ __attribute__((noinline)) void xcd_barrier(unsigned* bar_, unsigned x_, volatile __attribute__((address_space(3))) unsigned* st_, bool leader) {
    XcdBarrier b; b.bar = bar_; b.x = x_; b.st = st_;
    asm volatile("s_waitcnt vmcnt(0)" ::: "memory");
    __syncthreads();
    if (leader) {
        unsigned* bar = b.bar;
        __builtin_amdgcn_s_waitcnt(0);
        unsigned nloc = b.st[0], nx = b.st[1];
        if (nloc == 0u) { xcd_barrier_complete(bar, b.x, nloc, nx); b.st[0] = nloc; b.st[1] = nx; }
        const unsigned old = xb_add(&bar[XB_XSUB(b.x)], 1u);
        const unsigned gen = old / nloc;
        if (old + 1u == (gen + 1u) * nloc) {
            __builtin_amdgcn_fence(__ATOMIC_RELEASE, "agent");
            asm volatile("s_waitcnt vmcnt(0)" ::: "memory");
            const unsigned og = xb_add(&bar[XB_TOP], 1u);
            const unsigned tg = og / nx;
            if (og + 1u == (tg + 1u) * nx) xb_add(&bar[XB_TOPGEN], 1u);
            else XB_SPIN(xb_ld(&bar[XB_TOPGEN]) == tg, bar);
            __builtin_amdgcn_fence(__ATOMIC_ACQUIRE, "agent");
            xb_add(&bar[XB_XGEN(b.x)], 1u);
            asm volatile("s_waitcnt vmcnt(0)" ::: "memory");
        } else {
            XB_SPIN(xb_ld(&bar[XB_XGEN(b.x)]) == gen, bar);
            __builtin_amdgcn_fence(__ATOMIC_ACQUIRE, "agent");
            asm volatile("s_waitcnt vmcnt(0)" ::: "memory");
        }
    }
    __syncthreads();
}
__device__ __attribute__((noinline)) void grid_sync_fn() { cg::this_grid().sync(); }

struct Args { const float* in[14]; float* out; unsigned char* ws; int ph_lo, ph_hi; };
typedef const __attribute__((address_space(4))) Args* KArgs;
__device__ __forceinline__ KArgs kargs() { KArgs p = (KArgs)__builtin_amdgcn_kernarg_segment_ptr(); asm volatile("" : "+s"(p)); return p; }

__global__ void __launch_bounds__(512, 2) fwd_megakernel(Args args) {
    extern __shared__ __attribute__((aligned(16))) unsigned char lds[];
    const int wave = __builtin_amdgcn_readfirstlane((int)threadIdx.x >> 6);
    const int lane = (int)__builtin_amdgcn_mbcnt_hi(~0u, __builtin_amdgcn_mbcnt_lo(~0u, 0u)), tid = wave * 64 + lane;
    const int G = gridDim.x, bx = blockIdx.x;
#define KA_WS (kargs()->ws)
#define KA_IN(i) (kargs()->in[i])
#define KA_OUT (kargs()->out)
#define Win_t ((bf16r*)(KA_WS + WS_WIN))
#define Wpool_t ((bf16r*)(KA_WS + WS_WPOOL))
#define Wout_t ((bf16r*)(KA_WS + WS_WOUT))
#define Wup_t ((bf16r*)(KA_WS + WS_WUP))
#define Wdown_t ((bf16r*)(KA_WS + WS_WDOWN))
#define XN ((bf16r*)(KA_WS + WS_XN))
#define Z ((bf16r*)(KA_WS + WS_Z))
#define Dp ((bf16r*)(KA_WS + WS_D))
#define AM ((bf16r*)(KA_WS + WS_AM))
#define ACT ((bf16r*)(KA_WS + WS_ACT))
#define HS ((float*)(KA_WS + WS_HS))
#define HV ((float*)(KA_WS + WS_HV))
#define HG ((float*)(KA_WS + WS_HG))
#define SSQ ((float*)(KA_WS + WS_SS))
#define RSTD ((float*)(KA_WS + WS_RSTD))
    LAS unsigned char* ldsl = (LAS unsigned char*)lds;
    const int lo = kargs()->ph_lo, hi = kargs()->ph_hi;
#ifndef PHASE_MASK
#define PHASE_MASK 0x1ff
#endif
#define IN(k) (((PHASE_MASK >> (k)) & 1) && lo <= (k) && (k) < hi)
#ifndef PROBE_DUP
#define PROBE_DUP 0
#endif
#define NREP(k) (((PROBE_DUP >> (k)) & 1) ? 2 : 1)
#if MK_PER_PHASE
#define SEAM(k) do { } while (0)
#else
    volatile LAS unsigned* xbst = (volatile LAS unsigned*)(ldsl + XBST_OFF);
    if (tid == 0) { xbst[0] = 0u; xbst[1] = 0u; }
    unsigned xb_x = 0;
#define SEAM(k) do { if (IN(k) && IN((k) + 1)) { if ((k) == 0) { grid_sync_fn(); xb_x = xcd_barrier_post((unsigned*)(KA_WS + WS_BAR), xbst, tid == 0).x; } else { int ln_; asm volatile("v_mbcnt_lo_u32_b32 %0, -1, 0\n\tv_mbcnt_hi_u32_b32 %0, -1, %0" : "=v"(ln_)); xcd_barrier((unsigned*)(KA_WS + WS_BAR), xb_x, xbst, (wave == 0) && (ln_ == 0)); } } } while (0)
#endif
    const int gw = bx * 8 + wave, NGW = G * 8;
    const int gt = bx * 512 + tid, NGT = G * 512;

    if (IN(0)) {
        LAS float* scr = (LAS float*)(ldsl + wave * 16384);
        if (bx == 0) { unsigned* bw = (unsigned*)(KA_WS + WS_BAR); for (int i = tid; i < XCD_BAR_WORDS; i += 512) bw[i] = 0u; }
        constexpr int I_IN = 32 * 48  , I_FOLD = 4 * 32 * 16, I_OUT = 32 * 64;
        constexpr int NITEMS = I_IN + I_FOLD + I_OUT;
        const float* w_in = KA_IN(3); const float* w_out = KA_IN(8); const float* w_pool = KA_IN(6); unsigned char* wsb = KA_WS;
        for (int rp = 0; rp < NREP(0); ++rp) {
        for (int half = 0; half < 2; ++half) {
            const bool do_rows = (half == 0) == ((wave & 1) != 0);
            if (do_rows) { rms_rows_to_bf16(KA_IN(0), KA_IN(1), KA_IN(2), XN, gw, NGW, lane); continue; }
            for (int it = gw; it < NITEMS; it += NGW) {
                int r = it;
                if (r < I_FOLD) { fold_pool_item(w_in, w_pool, (bf16r*)(wsb + WS_WIN), scr, r, lane); continue; } r -= I_FOLD;
                if (r < I_IN) { const int kb = r / 48, nb = r % 48; transpose_item<0>(w_in, 2048, N_IN, (bf16r*)(wsb + WS_WIN), 0, scr, kb * 80 + nb, lane); continue; } r -= I_IN;
                transpose_item<0>(w_out, 2048, 2048, (bf16r*)(wsb + WS_WOUT), 0, scr, r, lane);
            }
        }
        }
    }
    SEAM(0);
#ifdef PROBE_SYNC
    for (int i_ = 0; i_ < PROBE_SYNC; ++i_) grid_sync_fn();
#endif
    if (IN(1)) {
        pg8::Gemm g{XN, Win_t, M_ALL, N_IN, 2048}; pg8::StaticOrder S; S.init(M_ALL, N_IN, G, bx); S.reps = NREP(1);
        pg8::EpiBf16 E{Z, N_IN, 0, 0, nullptr};
        pg8::gemm_phase<pg8::EpiBf16, pg8::StaticOrder, true, true>(ldsl, g, S, E, wave);
        {
            const int remu = (192 * 10) % G, nidle = remu ? G - remu : G, rank = remu ? bx - remu : bx;
            if (rank >= 0) {
                __syncthreads();
                LAS float* scr = (LAS float*)(ldsl + wave * 16384);
                constexpr int I_UP = 32 * 352, I_DOWN = 88 * 64;
                const float* w_up = KA_IN(10); const float* w_down = KA_IN(13); const float* g_ffn = KA_IN(9); unsigned char* wsb = KA_WS;
                for (int it = rank * 8 + wave; it < I_UP + I_DOWN; it += nidle * 8) {
                    if (it < I_UP) transpose_item<1>(w_up, 2048, N_UP, (bf16r*)(wsb + WS_WUP), 0, scr, it, lane, g_ffn);
                    else transpose_item<0>(w_down, D_FF, 2048, (bf16r*)(wsb + WS_WDOWN), 0, scr, it - I_UP, lane);
                }
            }
        }
    }
    SEAM(1);
    if (IN(2)) {
        bf16r* zb = Z; bf16r* amb = AM; const float* gk = KA_IN(5); const float* psc = KA_IN(7);
        const int sub = gt & 7, a = sub >> 2, ch = sub & 3;
        float invf[8];
#pragma unroll
        for (int i = 0; i < 8; ++i) invf[i] = __builtin_amdgcn_exp2f(-(float)(8 * ch + i) * 0.41524101186092029f) * 0.15915494309189535f;
        for (int item = gt >> 3; item < M_ALL * 2; item += NGT >> 3) {
            const int row = item >> 1, hh = 8 + (item & 1);
            const int t = row < M_P ? (row & (L_P - 1)) : ((row - M_P) & (L_S - 1));
            const float pos = (float)(a == 0 ? (t >> 6) : (t & 63));
            bf16r* p = zb + (size_t)row * N_IN + (hh < 8 ? hh * 128 : 1024 + (hh - 8) * 128) + 64 * a + 8 * ch;
            const float* gn = gk + 64 * a + 8 * ch;
            const u32x4g A = *(const u32x4g*)p, B = *(const u32x4g*)(p + 32);
            float x1[8] = {bf_lo(A.x), bf_hi(A.x), bf_lo(A.y), bf_hi(A.y), bf_lo(A.z), bf_hi(A.z), bf_lo(A.w), bf_hi(A.w)};
            float x2[8] = {bf_lo(B.x), bf_hi(B.x), bf_lo(B.y), bf_hi(B.y), bf_lo(B.z), bf_hi(B.z), bf_lo(B.w), bf_hi(B.w)};
            float ss = 0.f;
#pragma unroll
            for (int i = 0; i < 8; ++i) ss += x1[i] * x1[i] + x2[i] * x2[i];
            ss += __shfl_xor(ss, 1); ss += __shfl_xor(ss, 2); ss += __shfl_xor(ss, 4);
            const float rstd = 1.0f / sqrtf(ss * (1.f / 128.f) + RMS_EPS);
            const f32x4g g1a = *(const f32x4g*)gn, g1b = *(const f32x4g*)(gn + 4), g2a = *(const f32x4g*)(gn + 32), g2b = *(const f32x4g*)(gn + 36);
            const float g1[8] = {g1a.x, g1a.y, g1a.z, g1a.w, g1b.x, g1b.y, g1b.z, g1b.w}, g2[8] = {g2a.x, g2a.y, g2a.z, g2a.w, g2b.x, g2b.y, g2b.z, g2b.w};
            float o1[8], o2[8];
#pragma unroll
            for (int i = 0; i < 8; ++i) { const float y1 = x1[i] * rstd * g1[i], y2 = x2[i] * rstd * g2[i]; const float rev = pos * invf[i];
                const float cs = __builtin_amdgcn_cosf(rev), sn = __builtin_amdgcn_sinf(rev); o1[i] = y1 * cs - y2 * sn; o2[i] = y2 * cs + y1 * sn; }
            u32x4g OA, OB; OA.x = pg8::cvt_pk_bf16(o1[0], o1[1]); OA.y = pg8::cvt_pk_bf16(o1[2], o1[3]); OA.z = pg8::cvt_pk_bf16(o1[4], o1[5]); OA.w = pg8::cvt_pk_bf16(o1[6], o1[7]);
            OB.x = pg8::cvt_pk_bf16(o2[0], o2[1]); OB.y = pg8::cvt_pk_bf16(o2[2], o2[3]); OB.z = pg8::cvt_pk_bf16(o2[4], o2[5]); OB.w = pg8::cvt_pk_bf16(o2[6], o2[7]);
            *(u32x4g*)p = OA; *(u32x4g*)(p + 32) = OB;
        }
        for (int rp = 0; rp < NREP(2); ++rp)
        for (int item = gt; item < 4 * (M_ALL / 8) * 32; item += NGT) {
            const int g = item / ((M_ALL / 8) * 32), rem = item - g * ((M_ALL / 8) * 32), rb = rem >> 5, c8 = (rem & 31) * 8, row0 = rb * 8;
            const int L = row0 < M_P ? L_P : L_S, t0 = row0 < M_P ? (row0 & (L_P - 1)) : ((row0 - M_P) & (L_S - 1));
            const bf16r* vcol = zb + (size_t)(row0 - t0) * N_IN + 1536 + g * 256 + c8; bf16r* ocol = amb + (size_t)row0 * 2048 + 1024 + g * 256 + c8; const float* sc8 = psc + g * 256 + c8;
            if (g == 0) pool_item<1>(vcol, t0, L, sc8, ocol); else if (g == 1) pool_item<2>(vcol, t0, L, sc8, ocol); else if (g == 2) pool_item<4>(vcol, t0, L, sc8, ocol); else pool_item<8>(vcol, t0, L, sc8, ocol);
        }
    }
    SEAM(2);
    if (IN(3)) {
        for (int Lu_ = bx; Lu_ < 1536 * NREP(3); Lu_ += G) { const int Lu = Lu_ % 1536;
            const int r = Lu >> 8, cc = Lu & 255, x = cc & 7, slot = cc >> 3, b = x >> 1, kvh = x & 1;
            int head, qb, seq, row0;
            if (r < 4) { head = kvh * 4 + r; qb = slot; seq = L_S; row0 = M_P + b * L_S; }
            else { head = kvh * 4 + (r - 4) * 2 + (slot >> 4); qb = slot & 15; seq = L_P; row0 = b * L_P; }
            const bf16r* zb = Z;
            const att::bf16* Qb = (const att::bf16*)(zb + (size_t)(row0 + qb * 256) * N_IN + head * 128);
            const att::bf16* Kh = (const att::bf16*)(zb + (size_t)row0 * N_IN + 1024 + kvh * 128);
            const att::bf16* Vh = (const att::bf16*)(zb + (size_t)row0 * N_IN + 1280 + kvh * 128);
            unsigned* Ob = (unsigned*)(AM + (size_t)(row0 + qb * 256) * 2048 + head * 128);
            att::attn_dense_body<att::bf16>(Qb, Kh, Vh, Ob, seq, (char*)lds, KA_IN(4), qb * 256, KA_IN(5), wave);
        }
    }
    SEAM(3);
    if (IN(4)) {
        pg8::Gemm g{AM, Wout_t, M_ALL, 2048, 2048}; pg8::StaticOrder S; S.init(M_ALL, 2048, G, bx); S.reps = NREP(4);
        pg8::EpiResNorm E{KA_IN(0), KA_IN(1), XN, SSQ, (LAS float*)(ldsl + XCH_OFF)};
        pg8::gemm_phase<pg8::EpiResNorm, pg8::StaticOrder, true, true>(ldsl, g, S, E, wave);
    }
#ifdef PROBE_X4
    if (IN(4)) { __syncthreads();
        pg8::Gemm g{AM, Wout_t, M_ALL, 2048, 2048}; pg8::StaticOrder S; S.init(M_ALL, 2048, G, bx);
        pg8::EpiBf16 E{ACT, 2048, 0, 0, nullptr};
        pg8::gemm_phase<pg8::EpiBf16, pg8::StaticOrder, true, true>(ldsl, g, S, E, wave);
    }
#endif
    SEAM(4);
    if (IN(5)) {
        const float* ssq = SSQ; float* rstd = RSTD;
        for (int row = gt; row < M_ALL; row += NGT) { float q = 0.f;
#pragma unroll
            for (int p = 0; p < 8; ++p) q += ssq[(size_t)p * M_ALL + row];
            rstd[row] = 1.0f / sqrtf(q * (1.f / 2048.f) + RMS_EPS); }
    }
    SEAM(5);
    if (IN(6)) {
        pg8::Gemm g{XN, Wup_t, M_ALL, N_UP, 2048}; pg8::StaticOrder S; S.init(M_ALL, N_UP, G, bx); S.reps = NREP(6);
        pg8::EpiConvGlu E{ACT, KA_IN(11), KA_IN(12), HS, HV, HG, (LAS float*)(ldsl + XCH_OFF), RSTD};
        pg8::gemm_phase<pg8::EpiConvGlu, pg8::StaticOrder, true, true>(ldsl, g, S, E, wave);
    }
    SEAM(6);
    if (IN(7)) {
        const float* wc = KA_IN(11); const float* hs = HS; const float* hv = HV; const float* hg = HG; bf16r* actb = ACT;
        for (int item = gt; item < N_TILES_M * 2 * (D_FF / 4); item += NGT) {
            const int c4 = (item % (D_FF / 4)) * 4, pe = item / (D_FF / 4), pm = pe >> 1, e = pe & 1;
            const int tps = pm < 64 ? 16 : 32, ti = pm < 64 ? (pm & 15) : ((pm - 64) & 31);
            if (e == 0 ? (ti == 0) : (ti == tps - 1)) continue;
            const size_t ho = (size_t)pe * D_FF + c4;
            const f32x4g s0 = *(const f32x4g*)(hs + ho), v = *(const f32x4g*)(hv + ho);
            const f32x4g gn = e == 0 ? *(const f32x4g*)(hg + ((size_t)(pm - 1) * 2 + 1) * D_FF + c4) : *(const f32x4g*)(hg + ((size_t)(pm + 1) * 2 + 0) * D_FF + c4);
            const f32x4g w = *(const f32x4g*)(wc + (e == 0 ? 0 : 2 * D_FF) + c4);
            const f32x4g s = s0 + w * gn;
            u32x2g o; o.x = pg8::cvt_pk_bf16(pg8::silu_f(s.x) * v.x, pg8::silu_f(s.y) * v.y); o.y = pg8::cvt_pk_bf16(pg8::silu_f(s.z) * v.z, pg8::silu_f(s.w) * v.w);
            *(u32x2g*)(actb + ((size_t)pm * 256 + (e ? 255 : 0)) * D_FF + c4) = o;
        }
    }
    SEAM(7);
    if (IN(8)) {
        pg8::Gemm g{ACT, Wdown_t, M_ALL, 2048, D_FF}; pg8::StaticOrder S; S.init(M_ALL, 2048, G, bx); S.reps = NREP(8);
        pg8::EpiResOut E{XN, KA_OUT};
        pg8::gemm_phase<pg8::EpiResOut, pg8::StaticOrder, true, true>(ldsl, g, S, E, wave);
    }
#undef IN
#undef SEAM
}

extern "C" void kernel_launch(void* const* d_in, const int* in_sizes, int n_in, void* d_out, int out_size, void* d_ws, size_t ws_size, hipStream_t stream) {
    static int grid = 0;
    if (grid == 0) {
        if (n_in != 14 || in_sizes[0] != M_P * 2048 || in_sizes[1] != M_S * 2048 || out_size != M_ALL * 2048 || ws_size < WS_END) {
            fprintf(stderr, "kernel_launch: shape mismatch (n_in %d, in0 %d, in1 %d, out %d, ws %zu; need ws >= %zu)\n", n_in, n_in > 0 ? in_sizes[0] : -1, n_in > 1 ? in_sizes[1] : -1, out_size, ws_size, (size_t)WS_END);
            grid = -1; return; }
        int dev = 0, cus = 0, per_cu = 0;
        if (hipGetDevice(&dev) != hipSuccess || hipDeviceGetAttribute(&cus, hipDeviceAttributeMultiprocessorCount, dev) != hipSuccess) { grid = -1; return; }
        if (hipFuncSetAttribute((const void*)fwd_megakernel, hipFuncAttributeMaxDynamicSharedMemorySize, LDS_BYTES) != hipSuccess) { fprintf(stderr, "kernel_launch: hipFuncSetAttribute failed\n"); grid = -1; return; }
        if (hipOccupancyMaxActiveBlocksPerMultiprocessor(&per_cu, (const void*)fwd_megakernel, 512, LDS_BYTES) != hipSuccess || per_cu < 1) { fprintf(stderr, "kernel_launch: occupancy query gave %d\n", per_cu); per_cu = 1; }
        (void)hipGetLastError();
        grid = cus * 1;
        if (grid <= 0) { grid = -1; return; }
    }
    if (grid < 0) return;
    Args a{};
    for (int i = 0; i < 14; ++i) a.in[i] = (const float*)d_in[i];
    a.out = (float*)d_out; a.ws = (unsigned char*)d_ws;
#if MK_PER_PHASE
    for (int ph = 0; ph < N_PHASES; ++ph) { a.ph_lo = ph; a.ph_hi = ph + 1; hipLaunchKernelGGL(fwd_megakernel, dim3(grid), dim3(512), LDS_BYTES, stream, a); }
#else
    a.ph_lo = 0; a.ph_hi = N_PHASES;
    void* kargs[] = {&a};
    const hipError_t e = hipLaunchCooperativeKernel((const void*)fwd_megakernel, dim3(grid), dim3(512), kargs, LDS_BYTES, stream);
    if (e != hipSuccess) fprintf(stderr, "kernel_launch: cooperative launch failed: %s (grid %d)\n", hipGetErrorString(e), grid);
#endif
}
```

```cpp
#include <hip/hip_runtime.h>
#include <hip/hip_bf16.h>
#include <hip/hip_cooperative_groups.h>
#include <cstdio>
#include <cstdint>
#include <cmath>
namespace cg = cooperative_groups;

constexpr int DMODEL = 2048, M_P = 16384, M_S = 32768, M_ALL = 49152, L_P = 4096, L_S = 8192;
constexpr int N_IN = 2560, D_FF = 5632, N_UP = 11264, N_TILES_M = M_ALL / 256;
constexpr float RMS_EPS = 1e-6f;
namespace pg8 {
#define PG8_LAS __attribute__((address_space(3)))
typedef unsigned short bf16_t;
typedef short bf16x8 __attribute__((ext_vector_type(8)));
typedef float f32x4 __attribute__((ext_vector_type(4)));
typedef unsigned u32x4 __attribute__((ext_vector_type(4)));
constexpr int BM = 256, BK = 64, HALF = 128, HTB = HALF * BK * 2  , STAGE_BYTES = 8 * HTB, NXCD = 8, WGM = 8;

__host__ __device__ __forceinline__ int lds_byte(int r, int c) { const int st = (r >> 4) * 2 + (c >> 5), rr = r & 15, cc = c & 31, ob = rr * 64 + cc * 2; return st * 1024 + (ob ^ (((ob >> 9) & 1) << 5)); }
__host__ __device__ __forceinline__ void stage_rc(int b, int& R, int& C) { const int st = b / 1024, sb = b % 1024, swz = sb ^ (((sb >> 9) & 1) << 5); R = (st >> 1) * 16 + swz / 64; C = (st & 1) * 32 + (swz % 64) / 2; }
__host__ __device__ __forceinline__ int perm32(int rho) { const int n = rho >> 4, i = rho & 15; return 8 * (i >> 2) + 4 * n + (i & 3); }

struct Unit { int pm, pn; };
struct Gemm { const bf16_t* A; const bf16_t* Bt; int M, N, K; };

struct StaticOrder {
    int nM, nN, nwg, G, c, reps;
    __host__ __device__ void init(int M, int N, int G_, int c_) { nM = M / BM; nN = N / BM; nwg = nM * nN; G = G_; c = c_; reps = 1; }
    __host__ __device__ bool next(int i, Unit& u) const {
        const long L = (long)i * G + c; if (L >= (long)nwg * reps) return false;
        int wgid = (int)(L % nwg); { const int q = nwg / NXCD, r = nwg % NXCD, xcd = wgid % NXCD, off = wgid / NXCD; wgid = (xcd < r ? xcd * (q + 1) : r * (q + 1) + (xcd - r) * q) + off; }
        const int nig = WGM * nN, gid = wgid / nig, fm = gid * WGM, gsz = (nM - fm) < WGM ? (nM - fm) : WGM;
        u.pm = fm + ((wgid % nig) % gsz); u.pn = (wgid % nig) / gsz; return true;
    }
    __device__ __forceinline__ void a_ready(const Unit&) const {}
    __device__ __forceinline__ void done(const Unit&) const {}
};
__device__ __forceinline__ unsigned cvt_pk_bf16(float lo, float hi) { unsigned r; asm volatile("v_cvt_pk_bf16_f32 %0, %1, %2" : "=v"(r) : "v"(lo), "v"(hi)); return r; }
typedef float f32x2 __attribute__((ext_vector_type(2)));
constexpr int D_FF_C = 5632;
struct EpiBf16 {
    static constexpr bool PERM = true, AFTER_DRAIN = false;
    bf16_t* O; int ldc; int pm_mod; int col_off; const float* cscale;
    __device__ __forceinline__ void operator()(const f32x4 (&acc)[2][2][4][2], const Unit& u, int wr, int wc, int fr, int fq) const {
        const int pm = pm_mod ? (u.pm % pm_mod) : u.pm;
        const int row0 = pm * BM + wr * 64 + fr; const int lc = u.pn * BM + wc * 32 + 8 * fq;
        f32x4 sv[2][2];
#pragma unroll
        for (int bj = 0; bj < 2; ++bj)
#pragma unroll
            for (int n = 0; n < 2; ++n) sv[bj][n] = cscale ? *(const f32x4*)(cscale + lc + bj * HALF + 4 * n) : (f32x4){1.f, 1.f, 1.f, 1.f};
#pragma unroll
        for (int ai = 0; ai < 2; ++ai)
#pragma unroll
            for (int m = 0; m < 4; ++m) { bf16_t* rowp = O + (size_t)(row0 + ai * HALF + m * 16) * ldc + col_off + lc;
#pragma unroll
                for (int bj = 0; bj < 2; ++bj) { const f32x4 v0 = acc[ai][bj][m][0] * sv[bj][0], v1 = acc[ai][bj][m][1] * sv[bj][1];
                    u32x4 w; w.x = cvt_pk_bf16(v0[0], v0[1]); w.y = cvt_pk_bf16(v0[2], v0[3]); w.z = cvt_pk_bf16(v1[0], v1[1]); w.w = cvt_pk_bf16(v1[2], v1[3]);
                    *(u32x4*)(rowp + bj * HALF) = w; } }
    }
};
struct EpiResOut {
    static constexpr bool PERM = false, AFTER_DRAIN = false;
    const bf16_t* xb; float* out;
    __device__ __forceinline__ void operator()(const f32x4 (&acc)[2][2][4][2], const Unit& u, int wr, int wc, int fr, int fq) const {
        typedef unsigned u32x2 __attribute__((ext_vector_type(2)));
        const int col0 = u.pn * BM + wc * 32 + 4 * fq;
        u32x2 xv[2][4][2][2];
#pragma unroll
        for (int ai = 0; ai < 2; ++ai)
#pragma unroll
            for (int m = 0; m < 4; ++m) { const size_t r = (size_t)u.pm * BM + ai * HALF + wr * 64 + m * 16 + fr;
#pragma unroll
                for (int bj = 0; bj < 2; ++bj)
#pragma unroll
                    for (int n = 0; n < 2; ++n) xv[ai][m][bj][n] = __builtin_nontemporal_load((const u32x2*)(xb + r * 2048 + col0 + bj * HALF + n * 16)); }
#pragma unroll
        for (int ai = 0; ai < 2; ++ai)
#pragma unroll
            for (int m = 0; m < 4; ++m) { const size_t r = (size_t)u.pm * BM + ai * HALF + wr * 64 + m * 16 + fr; float* orow = out + r * 2048;
#pragma unroll
                for (int bj = 0; bj < 2; ++bj)
#pragma unroll
                    for (int n = 0; n < 2; ++n) { const u32x2 w = xv[ai][m][bj][n];
                        const f32x4 b = (f32x4){__uint_as_float(w.x << 16), __uint_as_float(w.x & 0xffff0000u), __uint_as_float(w.y << 16), __uint_as_float(w.y & 0xffff0000u)};
                        *(f32x4*)(orow + col0 + bj * HALF + n * 16) = b + acc[ai][bj][m][n]; } }
    }
};
struct EpiResNorm {
    static constexpr bool PERM = false, AFTER_DRAIN = false;
    const float* xp; const float* xs; bf16_t* xn; float* ss; PG8_LAS float* P;
    __device__ __forceinline__ void operator()(const f32x4 (&acc)[2][2][4][2], const Unit& u, int wr, int wc, int fr, int fq) const {
        typedef unsigned u32x2 __attribute__((ext_vector_type(2)));
        const int col0 = u.pn * BM + wc * 32 + 4 * fq;
#pragma unroll
        for (int ai = 0; ai < 2; ++ai) {
            f32x4 xv[4][2][2];
#pragma unroll
            for (int m = 0; m < 4; ++m) { const int r = u.pm * BM + ai * HALF + wr * 64 + m * 16 + fr;
                const float* xr = r < 16384 ? xp + (size_t)r * 2048 : xs + (size_t)(r - 16384) * 2048;
#pragma unroll
                for (int bj = 0; bj < 2; ++bj)
#pragma unroll
                    for (int n = 0; n < 2; ++n) xv[m][bj][n] = __builtin_nontemporal_load((const f32x4*)(xr + col0 + bj * HALF + n * 16)); }
            asm volatile("" ::: "memory");
#pragma unroll
            for (int m = 0; m < 4; ++m) { const int rl = ai * HALF + wr * 64 + m * 16 + fr, r = u.pm * BM + rl;
                bf16_t* nrow = xn + (size_t)r * 2048; float sq = 0.f;
#pragma unroll
                for (int bj = 0; bj < 2; ++bj)
#pragma unroll
                    for (int n = 0; n < 2; ++n) { const int c = col0 + bj * HALF + n * 16; const f32x4 v = xv[m][bj][n] + acc[ai][bj][m][n];
                        sq += (v[0] * v[0] + v[1] * v[1]) + (v[2] * v[2] + v[3] * v[3]);
                        u32x2 w; w.x = cvt_pk_bf16(v[0], v[1]); w.y = cvt_pk_bf16(v[2], v[3]); *(u32x2*)(nrow + c) = w; }
                sq += __shfl_xor(sq, 16); sq += __shfl_xor(sq, 32);
                if (fq == 0) P[rl * 4 + wc] = sq; }
            asm volatile("" ::: "memory");
        }
        asm volatile("s_waitcnt lgkmcnt(0)" ::: "memory"); __builtin_amdgcn_s_barrier(); asm volatile("" ::: "memory");
        const int t = (wr * 4 + wc) * 64 + fq * 16 + fr;
        if (t < 256) { const f32x4 p = *(const PG8_LAS f32x4*)(P + t * 4); ss[(size_t)u.pn * 49152 + u.pm * BM + t] = (p[0] + p[1]) + (p[2] + p[3]); }
    }
};
__device__ __forceinline__ float dpp_ror1(float v) { return __builtin_bit_cast(float, __builtin_amdgcn_update_dpp(0, __builtin_bit_cast(int, v), 0x121, 0xf, 0xf, false)); }
__device__ __forceinline__ float dpp_ror15(float v) { return __builtin_bit_cast(float, __builtin_amdgcn_update_dpp(0, __builtin_bit_cast(int, v), 0x12F, 0xf, 0xf, false)); }
__device__ __forceinline__ f32x4 ror1_4(f32x4 v) { return (f32x4){dpp_ror1(v[0]), dpp_ror1(v[1]), dpp_ror1(v[2]), dpp_ror1(v[3])}; }
__device__ __forceinline__ f32x4 ror15_4(f32x4 v) { return (f32x4){dpp_ror15(v[0]), dpp_ror15(v[1]), dpp_ror15(v[2]), dpp_ror15(v[3])}; }
__device__ __forceinline__ float silu_f(float s) { return s * __builtin_amdgcn_rcpf(1.0f + __builtin_amdgcn_exp2f(-1.4426950408889634f * s)); }
struct EpiConvGlu {
    static constexpr bool PERM = true, AFTER_DRAIN = false;
    bf16_t* act; const float* wconv; const float* bconv; float* hS; float* hV; float* hG; PG8_LAS float* xch; const float* rstd;
    __device__ __forceinline__ void operator()(f32x4 (&acc)[2][2][4][2], const Unit& u, int wr, int wc, int fr, int fq) const {
        const int cl = wc * 32 + 8 * fq, gc = u.pn * HALF + cl;
        f32x4 w0[2], w1[2], w2[2], bb[2];
#pragma unroll
        for (int n = 0; n < 2; ++n) { w0[n] = *(const f32x4*)(wconv + gc + 4 * n); w1[n] = *(const f32x4*)(wconv + D_FF_C + gc + 4 * n);
            w2[n] = *(const f32x4*)(wconv + 2 * D_FF_C + gc + 4 * n); bb[n] = *(const f32x4*)(bconv + gc + 4 * n); }
        float rs[2][4];
#pragma unroll
        for (int ai = 0; ai < 2; ++ai)
#pragma unroll
            for (int m = 0; m < 4; ++m) rs[ai][m] = rstd[u.pm * BM + ai * HALF + wr * 64 + m * 16 + fr];
#pragma unroll
        for (int ai = 0; ai < 2; ++ai)
#pragma unroll
            for (int m = 0; m < 4; ++m)
#pragma unroll
                for (int bj = 0; bj < 2; ++bj)
#pragma unroll
                    for (int n = 0; n < 2; ++n) acc[ai][bj][m][n] = acc[ai][bj][m][n] * rs[ai][m];
#pragma unroll
        for (int ai = 0; ai < 2; ++ai) { const int blk = 2 * ai + wr;
            if (fr == 0) { *(PG8_LAS f32x4*)(xch + (blk * 2 + 0) * HALF + cl) = acc[ai][0][0][0]; *(PG8_LAS f32x4*)(xch + (blk * 2 + 0) * HALF + cl + 4) = acc[ai][0][0][1]; }
            if (fr == 15) { *(PG8_LAS f32x4*)(xch + (blk * 2 + 1) * HALF + cl) = acc[ai][0][3][0]; *(PG8_LAS f32x4*)(xch + (blk * 2 + 1) * HALF + cl + 4) = acc[ai][0][3][1]; } }
        asm volatile("s_waitcnt lgkmcnt(0)" ::: "memory"); __builtin_amdgcn_s_barrier(); asm volatile("" ::: "memory");
#pragma unroll
        for (int ai = 0; ai < 2; ++ai) { const int blk = 2 * ai + wr;
            f32x4 top[2], bot[2];
#pragma unroll
            for (int n = 0; n < 2; ++n) {
                top[n] = blk > 0 ? *(const PG8_LAS f32x4*)(xch + ((blk - 1) * 2 + 1) * HALF + cl + 4 * n) : (f32x4){0.f, 0.f, 0.f, 0.f};
                bot[n] = blk < 3 ? *(const PG8_LAS f32x4*)(xch + ((blk + 1) * 2 + 0) * HALF + cl + 4 * n) : (f32x4){0.f, 0.f, 0.f, 0.f}; }
#pragma unroll
            for (int m = 0; m < 4; ++m) { const int rl = ai * HALF + wr * 64 + m * 16 + fr; const size_t r = (size_t)u.pm * BM + rl;
                u32x4 w;
#pragma unroll
                for (int n = 0; n < 2; ++n) {
                    const f32x4 g = acc[ai][0][m][n];
                    f32x4 up = ror1_4(g), dn = ror15_4(g);
                    if (m > 0) { const f32x4 pu = ror1_4(acc[ai][0][m > 0 ? m - 1 : 0][n]); if (fr == 0) up = pu; } else { if (fr == 0) up = top[n]; }
                    if (m < 3) { const f32x4 pd = ror15_4(acc[ai][0][m < 3 ? m + 1 : 3][n]); if (fr == 15) dn = pd; } else { if (fr == 15) dn = bot[n]; }
                    const f32x4 s = w0[n] * up + w1[n] * g + w2[n] * dn + bb[n];
                    const f32x4 v = acc[ai][1][m][n];
                    const f32x4 a = (f32x4){silu_f(s[0]) * v[0], silu_f(s[1]) * v[1], silu_f(s[2]) * v[2], silu_f(s[3]) * v[3]};
                    if (n == 0) { w.x = cvt_pk_bf16(a[0], a[1]); w.y = cvt_pk_bf16(a[2], a[3]); } else { w.z = cvt_pk_bf16(a[0], a[1]); w.w = cvt_pk_bf16(a[2], a[3]); }
                    if (rl == 0 || rl == 255) { const size_t ho = ((size_t)u.pm * 2 + (rl ? 1 : 0)) * D_FF_C + gc + 4 * n;
                        *(f32x4*)(hS + ho) = s; *(f32x4*)(hV + ho) = v; *(f32x4*)(hG + ho) = g; }
                }
                *(u32x4*)(act + r * D_FF_C + gc) = w; } }
    }
};
template <class Epi, class Sched, bool ALIGN_EPI = false, bool SP2 = false>
__device__ __forceinline__ void gemm_phase(PG8_LAS unsigned char* lds, const Gemm g, const Sched& S, const Epi& E, const int mk_wave) {
    const int lane = (int)__builtin_amdgcn_mbcnt_hi(~0u, __builtin_amdgcn_mbcnt_lo(~0u, 0u)), wid = mk_wave, tid = wid * 64 + lane, wr = wid >> 2, wc = wid & 3, fr = lane & 15, fq = lane >> 4;
    const int K = g.K, nt = K / BK;
    unsigned voffA[2], voffB[2];
#pragma unroll
    for (int i = 0; i < 2; ++i) { int R, C; stage_rc(tid * 16 + i * 8192, R, C); const int Rb = Epi::PERM ? ((R & ~31) + perm32(R & 31)) : R;
        voffA[i] = (unsigned)(R * K + C) * 2u; voffB[i] = (unsigned)(Rb * K + C) * 2u; }
    const size_t kstep = (size_t)(BK * 2);
    const size_t hstep = (size_t)HALF * K * 2;
    const size_t tstep = 2 * hstep;
    const unsigned ldsw = (unsigned)wid * 1024u;
    const int aoff = lds_byte(wr * 64 + fr, fq * 8), boff = lds_byte(wc * 32 + fr, fq * 8);
#define PG8_SA(b, h) (((b) * 2 + (h)) * HTB)
#define PG8_SB(b, h) ((4 + (b) * 2 + (h)) * HTB)
#define PG8_STAGE(bufoff, gbase, voff) do { _Pragma("unroll") for (int _i = 0; _i < 2; ++_i) \
        __builtin_amdgcn_global_load_lds((const unsigned*)((const char*)(gbase) + (voff)[_i]), (PG8_LAS unsigned*)(lds + (bufoff) + ldsw + _i * 8192), 16, 0, 0); } while (0)
#define PG8_LDA(dst, b, h) do { _Pragma("unroll") for (int m = 0; m < 4; ++m) _Pragma("unroll") for (int k = 0; k < 2; ++k) dst[m][k] = *(const PG8_LAS bf16x8*)(lds + PG8_SA(b, h) + aoff + m * 2048 + k * 1024); } while (0)
#define PG8_LDB(dst, b, h) do { _Pragma("unroll") for (int n = 0; n < 2; ++n) _Pragma("unroll") for (int k = 0; k < 2; ++k) dst[n][k] = *(const PG8_LAS bf16x8*)(lds + PG8_SB(b, h) + boff + n * 2048 + k * 1024); } while (0)
#define PG8_MMA(ai, bj, At, Bt) do { __builtin_amdgcn_s_setprio(1); _Pragma("unroll") for (int m = 0; m < 4; ++m) _Pragma("unroll") for (int n = 0; n < 2; ++n) _Pragma("unroll") for (int k = 0; k < 2; ++k) \
        acc[ai][bj][m][n] = __builtin_amdgcn_mfma_f32_16x16x32_bf16(Bt[n][k], At[m][k], acc[ai][bj][m][n], 0, 0, 0); __builtin_amdgcn_s_setprio(0); } while (0)
#define PG8_WAIT_V(n) asm volatile("s_waitcnt vmcnt(" #n ")" ::: "memory")
#define PG8_WAIT_L(n) asm volatile("s_waitcnt lgkmcnt(" #n ")" ::: "memory")
#define PG8_BAR __builtin_amdgcn_s_barrier()
#define PG8_SCHED __builtin_amdgcn_sched_barrier(0)
    Unit cur, nxt; int ui = 0;
    if (!S.next(0, cur)) return;
    f32x4 acc[2][2][4][2];
#pragma unroll
    for (int a = 0; a < 2; ++a)
#pragma unroll
        for (int b = 0; b < 2; ++b)
#pragma unroll
            for (int m = 0; m < 4; ++m)
#pragma unroll
                for (int n = 0; n < 2; ++n) acc[a][b][m][n] = (f32x4){0.f, 0.f, 0.f, 0.f};
    bf16x8 At[4][2], B0[2][2], B1[2][2];
    const char* cA = (const char*)g.A + (size_t)cur.pm * tstep; const char* cB = (const char*)g.Bt + (size_t)cur.pn * tstep;
    S.a_ready(cur);
    if constexpr (SP2) {
        PG8_STAGE(PG8_SB(0, 0), cB, voffB); PG8_STAGE(PG8_SB(0, 1), cB + hstep, voffB); PG8_STAGE(PG8_SA(0, 0), cA, voffA); PG8_STAGE(PG8_SA(0, 1), cA + hstep, voffA);
        if (wr == 1) PG8_BAR;
        PG8_WAIT_V(2); PG8_BAR;
        PG8_STAGE(PG8_SB(1, 0), cB + kstep, voffB); PG8_STAGE(PG8_SA(1, 0), cA + kstep, voffA); PG8_STAGE(PG8_SB(1, 1), cB + hstep + kstep, voffB);
        PG8_WAIT_V(6); PG8_BAR;
    } else {
        PG8_STAGE(PG8_SB(0, 0), cB, voffB); PG8_STAGE(PG8_SA(0, 0), cA, voffA); PG8_STAGE(PG8_SB(0, 1), cB + hstep, voffB); PG8_STAGE(PG8_SA(0, 1), cA + hstep, voffA);
        if (wr == 1) PG8_BAR;
        PG8_WAIT_V(4); PG8_BAR;
        PG8_STAGE(PG8_SB(1, 0), cB + kstep, voffB); PG8_STAGE(PG8_SA(1, 0), cA + kstep, voffA); PG8_STAGE(PG8_SB(1, 1), cB + hstep + kstep, voffB);
        PG8_WAIT_V(6); PG8_BAR;
    }
    for (;;) {
        const bool has_next = S.next(ui + 1, nxt);
        const char* nA = has_next ? (const char*)g.A + (size_t)nxt.pm * tstep : cA; const char* nB = has_next ? (const char*)g.Bt + (size_t)nxt.pn * tstep : cB;
        for (int t = 0; t < nt; t += 2) {
            const bool last = (t == nt - 2);
            const char* a1 = cA + (size_t)(t + 1) * kstep;
            const char* a2 = last ? nA : cA + (size_t)(t + 2) * kstep; const char* b2 = last ? nB : cB + (size_t)(t + 2) * kstep;
            const char* a3 = a2 + kstep; const char* b3 = b2 + kstep;
            if (last && has_next) S.a_ready(nxt);
            if constexpr (SP2) {
            PG8_LDB(B0, 0, 0); PG8_LDB(B1, 0, 1); PG8_SCHED; PG8_LDA(At, 0, 0); PG8_STAGE(PG8_SA(1, 1), a1 + hstep, voffA);
            PG8_WAIT_V(8); PG8_WAIT_L(0); PG8_BAR; PG8_MMA(0, 0, At, B0); PG8_MMA(0, 1, At, B1); PG8_BAR; PG8_SCHED;
            PG8_LDA(At, 0, 1); PG8_STAGE(PG8_SB(0, 0), b2, voffB); PG8_STAGE(PG8_SB(0, 1), b2 + hstep, voffB); PG8_STAGE(PG8_SA(0, 0), a2, voffA);
            PG8_WAIT_V(8); PG8_WAIT_L(0); PG8_BAR; PG8_MMA(1, 0, At, B0); PG8_MMA(1, 1, At, B1); PG8_BAR; PG8_SCHED;
            PG8_LDB(B0, 1, 0); PG8_LDB(B1, 1, 1); PG8_SCHED; PG8_LDA(At, 1, 0); PG8_STAGE(PG8_SA(0, 1), a2 + hstep, voffA);
            PG8_WAIT_V(8); PG8_WAIT_L(0); PG8_BAR; PG8_MMA(0, 0, At, B0); PG8_MMA(0, 1, At, B1); PG8_BAR; PG8_SCHED;
            PG8_LDA(At, 1, 1); PG8_STAGE(PG8_SB(1, 0), b3, voffB); PG8_STAGE(PG8_SB(1, 1), b3 + hstep, voffB); PG8_STAGE(PG8_SA(1, 0), a3, voffA);
            PG8_WAIT_V(8); PG8_WAIT_L(0); PG8_BAR; PG8_MMA(1, 0, At, B0); PG8_MMA(1, 1, At, B1); PG8_BAR; PG8_SCHED;
            } else {
            PG8_LDB(B0, 0, 0); PG8_SCHED; PG8_LDA(At, 0, 0); PG8_STAGE(PG8_SA(1, 1), a1 + hstep, voffA);
            PG8_WAIT_L(8); PG8_BAR; PG8_WAIT_L(0); PG8_MMA(0, 0, At, B0); PG8_BAR; PG8_SCHED;
            PG8_LDB(B1, 0, 1); PG8_STAGE(PG8_SB(0, 0), b2, voffB);
            PG8_BAR; PG8_WAIT_L(0); PG8_MMA(0, 1, At, B1); PG8_BAR;
            PG8_LDA(At, 0, 1); PG8_STAGE(PG8_SA(0, 0), a2, voffA);
            PG8_BAR; PG8_WAIT_L(0); PG8_MMA(1, 0, At, B0); PG8_BAR; PG8_SCHED;
            PG8_STAGE(PG8_SB(0, 1), b2 + hstep, voffB);
            PG8_WAIT_V(6); PG8_BAR; PG8_MMA(1, 1, At, B1); PG8_BAR;
            PG8_LDB(B0, 1, 0); PG8_SCHED; PG8_LDA(At, 1, 0); PG8_STAGE(PG8_SA(0, 1), a2 + hstep, voffA);
            PG8_WAIT_L(8); PG8_BAR; PG8_WAIT_L(0); PG8_MMA(0, 0, At, B0); PG8_BAR; PG8_SCHED;
            PG8_LDB(B1, 1, 1); PG8_STAGE(PG8_SB(1, 0), b3, voffB);
            PG8_BAR; PG8_WAIT_L(0); PG8_MMA(0, 1, At, B1); PG8_BAR;
            PG8_LDA(At, 1, 1); PG8_STAGE(PG8_SA(1, 0), a3, voffA);
            PG8_BAR; PG8_WAIT_L(0); PG8_MMA(1, 0, At, B0); PG8_BAR; PG8_SCHED;
            PG8_STAGE(PG8_SB(1, 1), b3 + hstep, voffB);
            PG8_WAIT_V(6); PG8_BAR; PG8_MMA(1, 1, At, B1); PG8_BAR;
            }
        }
        if constexpr (ALIGN_EPI) { if (wr == 0) PG8_BAR; }
        if constexpr (!Epi::AFTER_DRAIN) { E(acc, cur, wr, wc, fr, fq); S.done(cur); }
        if (!has_next) break;
#pragma unroll
        for (int a = 0; a < 2; ++a)
#pragma unroll
            for (int b = 0; b < 2; ++b)
#pragma unroll
                for (int m = 0; m < 4; ++m)
#pragma unroll
                    for (int n = 0; n < 2; ++n) acc[a][b][m][n] = (f32x4){0.f, 0.f, 0.f, 0.f};
        cur = nxt; cA = nA; cB = nB; ++ui;
        if constexpr (ALIGN_EPI) { if (wr == 1) PG8_BAR; }
    }
    PG8_WAIT_V(0);
    if constexpr (!ALIGN_EPI) { if (wr == 0) PG8_BAR; }
    PG8_BAR;
    if constexpr (Epi::AFTER_DRAIN) { E.fused(acc, cur, wr, wc, fr, fq, lds, wid, lane); S.done(cur); }
#undef PG8_SA
#undef PG8_SB
#undef PG8_STAGE
#undef PG8_LDA
#undef PG8_LDB
#undef PG8_MMA
#undef PG8_WAIT_V
#undef PG8_WAIT_L
#undef PG8_BAR
#undef PG8_SCHED
}
}
namespace att {
using bf16 = __hip_bfloat16;
constexpr int   D = 128, NW = 8, QBLK = 32, KVBLK = 64;
constexpr float SCALE = 0.088388347648318440f;
constexpr float THR = 8.f;
constexpr int SDEPTH = 2;
constexpr int LDQ = 2560, LDK = 2560, LDO = 2048;
constexpr size_t SHM_V = KVBLK * D * 2, SHM_K = KVBLK * D * 2, SHM_ATTN = 2 * SHM_V + 2 * SHM_K + NW * 64 * 4;
using bf16x8 = __attribute__((ext_vector_type(8))) short;
using s16x4  = __attribute__((ext_vector_type(4))) short;
using f32x16 = __attribute__((ext_vector_type(16))) float;
using f32x8  = __attribute__((ext_vector_type(8))) float;
using u32x4  = __attribute__((ext_vector_type(4))) unsigned;
#define KSWZ(row, colB) ((row) * 256 + ((colB) ^ (((row) & 7) << 4)))
#define SBAR() __builtin_amdgcn_sched_barrier(0)
__device__ __forceinline__ int crow(int r, int hi) { return (r & 3) + 8 * (r >> 2) + 4 * hi; }
__device__ __forceinline__ unsigned cvtpk(float lo, float hi) {
  unsigned r; asm volatile("v_cvt_pk_bf16_f32 %0, %1, %2" : "=v"(r) : "v"(lo), "v"(hi)); return r;
}
template <typename TIn> struct Stage;
template <> struct Stage<bf16>  { using T = bf16x8;
  __device__ static __forceinline__ T ld8(const bf16* p) { return *reinterpret_cast<const bf16x8*>(p); }
  __device__ static __forceinline__ bf16x8 tobf(T x) { return x; } };
template <> struct Stage<float> { using T = f32x8;
  __device__ static __forceinline__ T ld8(const float* p) { return *reinterpret_cast<const f32x8*>(p); }
  __device__ static __forceinline__ bf16x8 tobf(T x) {
    u32x4 w = {cvtpk(x[0], x[1]), cvtpk(x[2], x[3]), cvtpk(x[4], x[5]), cvtpk(x[6], x[7])}; return *reinterpret_cast<bf16x8*>(&w); } };

__device__ __forceinline__ void partialSM(f32x16& p0, f32x16& p1, float& m_reg, float& mn, float& alpha) {
  constexpr float C = SCALE * 1.4426950408889634f;
  float pmax = p0[0]; for (int r = 1; r < 16; ++r) pmax = fmaxf(pmax, p0[r]); for (int r = 0; r < 16; ++r) pmax = fmaxf(pmax, p1[r]);
  { auto rr = __builtin_amdgcn_permlane32_swap(__float_as_uint(pmax), __float_as_uint(pmax), false, false);
    pmax = fmaxf(__uint_as_float(rr[0]), __uint_as_float(rr[1])); }
  if (__builtin_expect(__all(pmax - m_reg <= THR / SCALE), 1)) { mn = m_reg; alpha = 1.f; }
  else { mn = fmaxf(m_reg, pmax); alpha = __builtin_amdgcn_exp2f((m_reg - mn) * C); m_reg = mn; }
  float mnC = -mn * C;
  for (int r = 0; r < 16; ++r) p0[r] = fmaf(p0[r], C, mnC); for (int r = 0; r < 16; ++r) p1[r] = fmaf(p1[r], C, mnC);
  for (int r = 0; r < 16; ++r) p0[r] = __builtin_amdgcn_exp2f(p0[r]);
}
__device__ __forceinline__ void finishSM(f32x16& p0, f32x16& p1, float alpha, float& l_reg, bf16x8& pa0, bf16x8& pa1, bf16x8& pa2, bf16x8& pa3) {
  for (int r = 0; r < 16; ++r) p1[r] = __builtin_amdgcn_exp2f(p1[r]);
  float ps = 0; for (int r = 0; r < 16; ++r) ps += p0[r]; for (int r = 0; r < 16; ++r) ps += p1[r];
  { auto rr = __builtin_amdgcn_permlane32_swap(__float_as_uint(ps), __float_as_uint(ps), false, false);
    ps = __uint_as_float(rr[0]) + __uint_as_float(rr[1]); }
  l_reg = l_reg * alpha + ps;
#define PK4(P, BASE, OUT) do { unsigned a0 = cvtpk(P[BASE + 0], P[BASE + 1]), a1 = cvtpk(P[BASE + 2], P[BASE + 3]);   \
    unsigned b0 = cvtpk(P[BASE + 4], P[BASE + 5]), b1 = cvtpk(P[BASE + 6], P[BASE + 7]);                              \
    auto r0 = __builtin_amdgcn_permlane32_swap(a0, b0, false, false); auto r1 = __builtin_amdgcn_permlane32_swap(a1, b1, false, false); \
    u32x4 w = {r0[0], r1[0], r0[1], r1[1]}; OUT = *reinterpret_cast<bf16x8*>(&w); } while (0)
  PK4(p0, 0, pa0); PK4(p0, 8, pa1); PK4(p1, 0, pa2); PK4(p1, 8, pa3);
#undef PK4
}
__device__ __forceinline__ void partialSM2(f32x16& p0, f32x16& p1, float mnC) {
  constexpr float C = SCALE * 1.4426950408889634f;
  for (int r = 0; r < 16; ++r) p0[r] = fmaf(p0[r], C, mnC); for (int r = 0; r < 16; ++r) p1[r] = fmaf(p1[r], C, mnC);
  for (int r = 0; r < 16; ++r) p0[r] = __builtin_amdgcn_exp2f(p0[r]);
}
__device__ __forceinline__ void finishSM2(f32x16& p0, f32x16& p1, float& l_reg, bf16x8& pa0, bf16x8& pa1, bf16x8& pa2, bf16x8& pa3) {
  for (int r = 0; r < 16; ++r) p1[r] = __builtin_amdgcn_exp2f(p1[r]);
  float ps = 0; for (int r = 0; r < 16; ++r) ps += p0[r]; for (int r = 0; r < 16; ++r) ps += p1[r];
  { auto rr = __builtin_amdgcn_permlane32_swap(__float_as_uint(ps), __float_as_uint(ps), false, false);
    ps = __uint_as_float(rr[0]) + __uint_as_float(rr[1]); }
  l_reg += ps;
#define PK4(P, BASE, OUT) do { unsigned a0 = cvtpk(P[BASE + 0], P[BASE + 1]), a1 = cvtpk(P[BASE + 2], P[BASE + 3]);   \
    unsigned b0 = cvtpk(P[BASE + 4], P[BASE + 5]), b1 = cvtpk(P[BASE + 6], P[BASE + 7]);                              \
    auto r0 = __builtin_amdgcn_permlane32_swap(a0, b0, false, false); auto r1 = __builtin_amdgcn_permlane32_swap(a1, b1, false, false); \
    u32x4 w = {r0[0], r1[0], r0[1], r1[1]}; OUT = *reinterpret_cast<bf16x8*>(&w); } while (0)
  PK4(p0, 0, pa0); PK4(p0, 8, pa1); PK4(p1, 0, pa2); PK4(p1, 8, pa3);
#undef PK4
}
__device__ __forceinline__ void qkt(f32x16& p0, f32x16& p1, const bf16* Ks, const bf16x8* qr, int r32, int hi) {
  p0 = f32x16{}; p1 = f32x16{};
  for (int d0 = 0; d0 < 8; ++d0) { int cb = (d0 * 16 + hi * 8) * 2;
    bf16x8 b0 = *reinterpret_cast<const bf16x8*>((const char*)Ks + KSWZ(r32, cb));
    bf16x8 b1 = *reinterpret_cast<const bf16x8*>((const char*)Ks + KSWZ(32 + r32, cb));
    p0 = __builtin_amdgcn_mfma_f32_32x32x16_bf16(b0, qr[d0], p0, 0, 0, 0);
    p1 = __builtin_amdgcn_mfma_f32_32x32x16_bf16(b1, qr[d0], p1, 0, 0, 0); }
}
__device__ __forceinline__ int v_st(int k, int c) { const int kk = (k & ~0xC) | ((k & 4) << 1) | ((k & 8) >> 1); return ((kk >> 3) * 4 + (c >> 5)) * 512 + ((kk & 7) * 32 + (c & 31)) * 2; }
__device__ __forceinline__ int v_rd_base(int lane) { return ((lane & 3) << 3) | (((lane >> 2) & 3) << 6) | (((lane >> 4) & 1) << 5) | (((lane >> 5) & 1) << 8); }
constexpr int v_rd_off(int d0, int ks, int half) { return d0 * 512 + ks * 4096 + half * 2048; }
template <int OFF> __device__ __forceinline__ s16x4 tr_read(int vb) {
  s16x4 r; asm volatile("ds_read_b64_tr_b16 %0, %1 offset:%2" : "=&v"(r) : "v"(vb), "i"(OFF) : "memory"); return r;
}
template <int D0> __device__ __forceinline__ void pv_one(f32x16& od, int vb, bf16x8 pa0, bf16x8 pa1, bf16x8 pa2, bf16x8 pa3) {
  const s16x4 l0 = tr_read<v_rd_off(D0, 0, 0)>(vb), h0 = tr_read<v_rd_off(D0, 0, 1)>(vb), l1 = tr_read<v_rd_off(D0, 1, 0)>(vb), h1 = tr_read<v_rd_off(D0, 1, 1)>(vb);
  const s16x4 l2 = tr_read<v_rd_off(D0, 2, 0)>(vb), h2 = tr_read<v_rd_off(D0, 2, 1)>(vb), l3 = tr_read<v_rd_off(D0, 3, 0)>(vb), h3 = tr_read<v_rd_off(D0, 3, 1)>(vb);
  asm volatile("s_waitcnt lgkmcnt(0)" ::: "memory"); SBAR();
#define PK(L, H) (bf16x8){L[0], L[1], L[2], L[3], H[0], H[1], H[2], H[3]}
  od = __builtin_amdgcn_mfma_f32_32x32x16_bf16(pa0, PK(l0, h0), od, 0, 0, 0);
  od = __builtin_amdgcn_mfma_f32_32x32x16_bf16(pa1, PK(l1, h1), od, 0, 0, 0);
  od = __builtin_amdgcn_mfma_f32_32x32x16_bf16(pa2, PK(l2, h2), od, 0, 0, 0);
  od = __builtin_amdgcn_mfma_f32_32x32x16_bf16(pa3, PK(l3, h3), od, 0, 0, 0);
#undef PK
}
__device__ __forceinline__ void pv_d0(f32x16* o, int vb, bf16x8 pa0, bf16x8 pa1, bf16x8 pa2, bf16x8 pa3) {
  pv_one<0>(o[0], vb, pa0, pa1, pa2, pa3); pv_one<1>(o[1], vb, pa0, pa1, pa2, pa3); pv_one<2>(o[2], vb, pa0, pa1, pa2, pa3); pv_one<3>(o[3], vb, pa0, pa1, pa2, pa3);
}
template <typename TQ>
__device__ __forceinline__ void attn_dense_body(const TQ* __restrict__ Qb, const bf16* __restrict__ Kh, const bf16* __restrict__ Vh,
                                                unsigned* __restrict__ Ob, int seq, char* lds, const float* __restrict__ gq, int tq0, const float* __restrict__ gk, const int mk_wave) {
  using St = Stage<bf16>; using SQ = Stage<TQ>;
  const int lane = (int)__builtin_amdgcn_mbcnt_hi(~0u, __builtin_amdgcn_mbcnt_lo(~0u, 0u)), wid = mk_wave, tid = wid * 64 + lane, r32 = lane & 31, hi = lane >> 5;
  bf16* V_lds = (bf16*)lds; bf16* K_lds = (bf16*)(lds + 2 * SHM_V);
  float* ws = (float*)(lds + 2 * SHM_V + 2 * SHM_K) + wid * 64; float* li_l = ws; float* al_l = ws + 32;
  float l_reg = 0; f32x16 o[4] = {}; bf16x8 qr[8];
  float mnC;
  { float a = fmaxf(fabsf(gq[lane]), fabsf(gq[lane + 64])), b = fmaxf(fabsf(gk[lane]), fabsf(gk[lane + 64]));
#pragma unroll
    for (int o_ = 1; o_ < 64; o_ <<= 1) { a = fmaxf(a, __shfl_xor(a, o_)); b = fmaxf(b, __shfl_xor(b, o_)); }
    mnC = -(128.0f * a * b) * (SCALE * 1.4426950408889634f); }
  const TQ* Qw = Qb + (long)(wid * QBLK + r32) * LDQ + hi * 8;
#pragma unroll
  for (int d0 = 0; d0 < 8; ++d0) qr[d0] = SQ::tobf(SQ::ld8(Qw + d0 * 16));
  {
    float ss = 0.f;
#pragma unroll
    for (int d0 = 0; d0 < 8; ++d0)
#pragma unroll
      for (int j = 0; j < 8; ++j) { const float x = __uint_as_float(((unsigned)(unsigned short)qr[d0][j]) << 16); ss += x * x; }
    ss += __shfl_xor(ss, 32);
    const float rstd = 1.0f / sqrtf(ss * (1.f / 128.f) + 1e-6f);
    const int tq = tq0 + wid * QBLK + r32;
    int hio = hi * 8; asm volatile("" : "+v"(hio));
#pragma unroll
    for (int ax = 0; ax < 2; ++ax) { const float pos = (float)(ax == 0 ? (tq >> 6) : (tq & 63));
#pragma unroll
      for (int dd = 0; dd < 2; ++dd) { const int da = ax * 4 + dd, db = da + 2;
        const f32x8 ga = *reinterpret_cast<const f32x8*>(gq + da * 16 + hi * 8), gb = *reinterpret_cast<const f32x8*>(gq + db * 16 + hi * 8);
        float oa[8], ob[8];
#pragma unroll
        for (int j = 0; j < 8; ++j) { const float rev = pos * (__builtin_amdgcn_exp2f(-(float)(dd * 16 + hio + j) * 0.41524101186092029f) * 0.15915494309189535f);
          const float cs = __builtin_amdgcn_cosf(rev), sn = __builtin_amdgcn_sinf(rev);
          const float x1 = __uint_as_float(((unsigned)(unsigned short)qr[da][j]) << 16) * rstd * ga[j], x2 = __uint_as_float(((unsigned)(unsigned short)qr[db][j]) << 16) * rstd * gb[j];
          oa[j] = x1 * cs - x2 * sn; ob[j] = x2 * cs + x1 * sn; }
        u32x4 wa = {cvtpk(oa[0], oa[1]), cvtpk(oa[2], oa[3]), cvtpk(oa[4], oa[5]), cvtpk(oa[6], oa[7])}, wb = {cvtpk(ob[0], ob[1]), cvtpk(ob[2], ob[3]), cvtpk(ob[4], ob[5]), cvtpk(ob[6], ob[7])};
        qr[da] = *reinterpret_cast<bf16x8*>(&wa); qr[db] = *reinterpret_cast<bf16x8*>(&wb);
        asm volatile("" : "+v"(qr[da]), "+v"(qr[db])); } }
  }
  const int sr = tid >> 4, sc = (tid & 15) * 8, vst0 = v_st(sr, sc), vst1 = v_st(32 + sr, sc);
  const int vb0 = (int)(uintptr_t)V_lds + v_rd_base(lane);
  struct { typename St::T vs0, vs1, ks0, ks1; } sr_[SDEPTH];
#define SLOAD(i, k0) do { sr_[i].vs0 = St::ld8(&Vh[(long)((k0) + sr) * LDK + sc]); sr_[i].vs1 = St::ld8(&Vh[(long)((k0) + 32 + sr) * LDK + sc]); \
    sr_[i].ks0 = St::ld8(&Kh[(long)((k0) + sr) * LDK + sc]); sr_[i].ks1 = St::ld8(&Kh[(long)((k0) + 32 + sr) * LDK + sc]); } while (0)
#define SWRITE(b, i) do { *(bf16x8*)((char*)V_lds + (b) * SHM_V + vst0) = St::tobf(sr_[i].vs0);          \
    *(bf16x8*)((char*)V_lds + (b) * SHM_V + vst1) = St::tobf(sr_[i].vs1); int kc = sc * 2;               \
    *(bf16x8*)((char*)K_lds + (b) * SHM_K + KSWZ(sr, kc)) = St::tobf(sr_[i].ks0);                       \
    *(bf16x8*)((char*)K_lds + (b) * SHM_K + KSWZ(32 + sr, kc)) = St::tobf(sr_[i].ks1); } while (0)
#define SWAIT() do { if constexpr (SDEPTH == 2) asm volatile("s_waitcnt vmcnt(4)" ::: "memory"); else asm volatile("s_waitcnt vmcnt(0)" ::: "memory"); } while (0)
#define RESC(a) do { if (__any((a) < 1.f)) { if (hi == 0) al_l[r32] = (a); asm volatile("s_waitcnt lgkmcnt(0)" ::: "memory"); \
    for (int d = 0; d < 4; ++d) for (int r = 0; r < 16; ++r) o[d][r] *= al_l[crow(r, hi)]; } } while (0)
  f32x16 pA0, pA1, pB0, pB1; float mnA, mnB, alA, alB; bf16x8 pa0, pa1, pa2, pa3; const int NT = seq / KVBLK;
  constexpr int SE = 0, SO = SDEPTH - 1;
  SLOAD(SE, 0); asm volatile("s_waitcnt vmcnt(0)" ::: "memory"); SWRITE(0, SE); __syncthreads();
  qkt(pA0, pA1, K_lds, qr, r32, hi); partialSM2(pA0, pA1, mnC);
  SLOAD(SO, KVBLK); if constexpr (SDEPTH == 2) { if (2 < NT) SLOAD(SE, 2 * KVBLK); }
  SWAIT(); SWRITE(1, SO); __syncthreads();
  for (int j = 1; j + 1 < NT; j += 2) {
    SBAR(); qkt(pB0, pB1, (bf16*)((char*)K_lds + SHM_K), qr, r32, hi);
    finishSM2(pA0, pA1, l_reg, pa0, pa1, pa2, pa3); SBAR();
    SLOAD(SO, (j + SDEPTH) * KVBLK); SBAR();
    pv_d0(o, vb0, pa0, pa1, pa2, pa3); partialSM2(pB0, pB1, mnC);
    __syncthreads(); SWAIT(); SWRITE(0, SE);
    __syncthreads();
    SBAR(); qkt(pA0, pA1, K_lds, qr, r32, hi);
    finishSM2(pB0, pB1, l_reg, pa0, pa1, pa2, pa3); SBAR();
    if (SDEPTH == 1 || j + 3 < NT) SLOAD(SE, (j + 1 + SDEPTH) * KVBLK); SBAR();
    pv_d0(o, vb0 + (int)SHM_V, pa0, pa1, pa2, pa3); partialSM2(pA0, pA1, mnC);
    __syncthreads(); SWAIT(); SWRITE(1, SO);
    __syncthreads();
  }
  SBAR(); qkt(pB0, pB1, (bf16*)((char*)K_lds + SHM_K), qr, r32, hi);
  finishSM2(pA0, pA1, l_reg, pa0, pa1, pa2, pa3); SBAR();
  pv_d0(o, vb0, pa0, pa1, pa2, pa3); partialSM2(pB0, pB1, mnC);
  __syncthreads();
  finishSM2(pB0, pB1, l_reg, pa0, pa1, pa2, pa3); SBAR();
  pv_d0(o, vb0 + (int)SHM_V, pa0, pa1, pa2, pa3);
  int lane_e = lane; asm volatile("" : "+v"(lane_e));
  const int r32e = lane_e & 31, hie = lane_e >> 5;
  if (hie == 0) li_l[r32e] = l_reg; asm volatile("s_waitcnt lgkmcnt(0)" ::: "memory");
  float rli[16];
#pragma unroll
  for (int r = 0; r < 16; ++r) rli[r] = __builtin_amdgcn_rcpf(li_l[crow(r, hie)]);
  unsigned* Ow = Ob + (long)(wid * QBLK) * (LDO / 2);
#pragma unroll
  for (int r = 0; r < 16; r += 2) {
#pragma unroll
    for (int d0 = 0; d0 < 4; ++d0) {
      const float x = o[d0][r] * rli[r], y = o[d0][r + 1] * rli[r + 1];
      const float snd = (lane_e & 1) ? x : y; const float rcv = __shfl_xor(snd, 1);
      const unsigned w = (lane_e & 1) ? cvtpk(rcv, y) : cvtpk(x, rcv);
      const int orow = crow((lane_e & 1) ? r + 1 : r, hie);
      Ow[(long)orow * (LDO / 2) + ((d0 * 32 + (r32e & ~1)) >> 1)] = w; } }
  __syncthreads();
#undef SLOAD
#undef SWRITE
#undef SWAIT
#undef RESC
}
}

#ifndef MK_PER_PHASE
#define MK_PER_PHASE 0
#endif
#define LAS __attribute__((address_space(3)))
typedef unsigned short bf16r;
typedef float f32x4g __attribute__((ext_vector_type(4)));
typedef unsigned u32x4g __attribute__((ext_vector_type(4)));
typedef unsigned u32x2g __attribute__((ext_vector_type(2)));
constexpr size_t MiB = 1u << 20;
constexpr size_t WS_WIN = 2 * MiB, WS_WPOOL = 12 * MiB, WS_WOUT = 13 * MiB, WS_WUP = 21 * MiB, WS_WDOWN = 65 * MiB;
constexpr size_t WS_XN = 96 * MiB;
constexpr size_t WS_Z = 288 * MiB;
constexpr size_t WS_D = 528 * MiB;
constexpr size_t WS_AM = 624 * MiB;
constexpr size_t WS_ACT = 288 * MiB;
constexpr size_t WS_HS = 816 * MiB, WS_HV = 825 * MiB, WS_HG = 834 * MiB, WS_SS = 843 * MiB, WS_RSTD = 845 * MiB, WS_END = 846 * MiB;
static_assert(WS_WDOWN + (size_t)2048 * 5632 * 2 <= WS_XN && WS_XN + (size_t)M_ALL * 2048 * 2 <= WS_Z && WS_Z + (size_t)M_ALL * 2560 * 2 <= WS_D && WS_D + (size_t)M_ALL * 1024 * 2 <= WS_AM &&
              WS_AM + (size_t)M_ALL * 2048 * 2 <= WS_HS && WS_ACT + (size_t)M_ALL * 5632 * 2 <= WS_HS && WS_HS + (size_t)192 * 2 * 5632 * 4 <= WS_HV, "d_ws map");
constexpr int RING_BYTES = 131072, XCH_OFF = RING_BYTES, XBST_OFF = RING_BYTES + 12288, LDS_BYTES = 147456;
constexpr size_t WS_BAR = 0;
constexpr int N_PHASES = 9;

__device__ __forceinline__ float wave_sum(float v) {
#pragma unroll
    for (int o = 1; o < 64; o <<= 1) v += __shfl_xor(v, o);
    return v;
}
__device__ __forceinline__ float bf_lo(unsigned w) { return __uint_as_float(w << 16); }
__device__ __forceinline__ float bf_hi(unsigned w) { return __uint_as_float(w & 0xffff0000u); }
#define LDS_WAIT() asm volatile("s_waitcnt lgkmcnt(0)" ::: "memory")

template <int MODE> __device__ __forceinline__ void transpose_item(const float* W, int K, int N, bf16r* WT, int row_off, LAS float* scr, int item, int lane, const float* kscale = nullptr) {
    const int nblk = N / 32, kb = item / nblk, nb = item % nblk, k0 = 64 * kb, n0 = 32 * nb;
    float tv[32];
#pragma unroll
    for (int i = 0; i < 32; ++i) { const int kk = 2 * i + (lane >> 5); tv[i] = __builtin_nontemporal_load(&W[(size_t)(k0 + kk) * N + n0 + (lane & 31)]); }
    if (MODE == 1) {
        float ks[32];
#pragma unroll
        for (int i = 0; i < 32; ++i) ks[i] = kscale[k0 + 2 * i + (lane >> 5)];
#pragma unroll
        for (int i = 0; i < 32; ++i) tv[i] *= ks[i];
    }
#pragma unroll
    for (int i = 0; i < 32; ++i) { const int kk = 2 * i + (lane >> 5); scr[kk * 33 + (lane & 31)] = tv[i]; }
    LDS_WAIT(); asm volatile("" ::: "memory");
    int d0 = row_off + n0;
    if (MODE == 1) d0 = n0 < 5632 ? 256 * (n0 / 128) + (n0 % 128) : 256 * ((n0 - 5632) / 128) + 128 + ((n0 - 5632) % 128);
    const int c = lane & 7;
#pragma unroll
    for (int j = 0; j < 4; ++j) { const int n = (lane >> 3) + 8 * j; const LAS float* s = scr + (8 * c) * 33 + n;
        u32x4g o; o.x = pg8::cvt_pk_bf16(s[0 * 33], s[1 * 33]); o.y = pg8::cvt_pk_bf16(s[2 * 33], s[3 * 33]); o.z = pg8::cvt_pk_bf16(s[4 * 33], s[5 * 33]); o.w = pg8::cvt_pk_bf16(s[6 * 33], s[7 * 33]);
        *(u32x4g*)(WT + (size_t)(d0 + n) * K + k0 + 8 * c) = o; }
    LDS_WAIT(); asm volatile("" ::: "memory");
}
__device__ __forceinline__ void rms_rows_to_bf16(const float* x_p, const float* x_s, const float* g, bf16r* xn, int gw, int NGW, int lane) {
    f32x4g gv[8], cur[8], nxt[8];
    const f32x4g* gr = (const f32x4g*)g + lane;
#pragma unroll
    for (int j = 0; j < 8; ++j) gv[j] = gr[64 * j];
    int m = gw;
    if (m < M_ALL) { const f32x4g* xr = (const f32x4g*)(m < M_P ? x_p + (size_t)m * 2048 : x_s + (size_t)(m - M_P) * 2048) + lane;
#pragma unroll
        for (int j = 0; j < 8; ++j) cur[j] = __builtin_nontemporal_load(&xr[64 * j]); }
    for (; m < M_ALL; m += NGW) {
        const int mn = m + NGW;
        if (mn < M_ALL) { const f32x4g* xr = (const f32x4g*)(mn < M_P ? x_p + (size_t)mn * 2048 : x_s + (size_t)(mn - M_P) * 2048) + lane;
#pragma unroll
            for (int j = 0; j < 8; ++j) nxt[j] = __builtin_nontemporal_load(&xr[64 * j]); }
        float s = 0.f;
#pragma unroll
        for (int j = 0; j < 8; ++j) s += (cur[j].x * cur[j].x + cur[j].y * cur[j].y) + (cur[j].z * cur[j].z + cur[j].w * cur[j].w);
        const float rstd = 1.0f / sqrtf(wave_sum(s) * (1.f / 2048.f) + RMS_EPS);
        u32x2g* o8 = (u32x2g*)(xn + (size_t)m * 2048) + lane;
#pragma unroll
        for (int j = 0; j < 8; ++j) { const f32x4g y = cur[j] * rstd * gv[j]; u32x2g w; w.x = pg8::cvt_pk_bf16(y.x, y.y); w.y = pg8::cvt_pk_bf16(y.z, y.w); o8[64 * j] = w; }
#pragma unroll
        for (int j = 0; j < 8; ++j) cur[j] = nxt[j];
    }
}
template <int HW> __device__ __forceinline__ void pool_item(const bf16r* vcol  , int t0, int L, const float* sc8, bf16r* ocol  ) {
    constexpr int RB = 8, NR = 2 * HW + RB - 1;
    u32x4g rows[NR];
#pragma unroll
    for (int j = 0; j < NR; ++j) { const int t = t0 - HW + j; rows[j] = (t >= 0 && t < L) ? *(const u32x4g*)(vcol + (size_t)t * N_IN) : (u32x4g){0u, 0u, 0u, 0u}; }
    const f32x4g sa = *(const f32x4g*)sc8, sb = *(const f32x4g*)(sc8 + 4);
    float S[8] = {0.f, 0.f, 0.f, 0.f, 0.f, 0.f, 0.f, 0.f};
#define POOL_ACC(R, SGN) do { S[0] += SGN bf_lo(R.x); S[1] += SGN bf_hi(R.x); S[2] += SGN bf_lo(R.y); S[3] += SGN bf_hi(R.y); S[4] += SGN bf_lo(R.z); S[5] += SGN bf_hi(R.z); S[6] += SGN bf_lo(R.w); S[7] += SGN bf_hi(R.w); } while (0)
#pragma unroll
    for (int j = 0; j < 2 * HW; ++j) POOL_ACC(rows[j], +);
#pragma unroll
    for (int i = 0; i < RB; ++i) { const int t = t0 + i; const int lo = t - HW < 0 ? 0 : t - HW, hi = t + HW > L ? L : t + HW; const float rc = 1.0f / (float)(hi - lo);
        const u32x4g U = rows[i + HW];
        u32x4g O; O.x = pg8::cvt_pk_bf16((S[0] * rc - bf_lo(U.x)) * sa.x, (S[1] * rc - bf_hi(U.x)) * sa.y); O.y = pg8::cvt_pk_bf16((S[2] * rc - bf_lo(U.y)) * sa.z, (S[3] * rc - bf_hi(U.y)) * sa.w);
        O.z = pg8::cvt_pk_bf16((S[4] * rc - bf_lo(U.z)) * sb.x, (S[5] * rc - bf_hi(U.z)) * sb.y); O.w = pg8::cvt_pk_bf16((S[6] * rc - bf_lo(U.w)) * sb.z, (S[7] * rc - bf_hi(U.w)) * sb.w);
        *(u32x4g*)(ocol + (size_t)i * 2048) = O;
        if (i < RB - 1) { POOL_ACC(rows[i + 2 * HW], +); POOL_ACC(rows[i], -); } }
#undef POOL_ACC
}
__device__ __forceinline__ void fold_pool_item(const float* w_in, const float* w_pool, bf16r* WT, LAS float* scr, int item, int lane) {
    const int g = item >> 9, kb = (item >> 2) & 127, db = item & 3, k0 = kb * 16, d0 = db * 64;
    f32x4g av[16];
#pragma unroll
    for (int kk = 0; kk < 16; ++kk) av[kk] = __builtin_nontemporal_load((const f32x4g*)(w_in + (size_t)(k0 + kk) * N_IN + 1536 + g * 256 + lane * 4));
#pragma unroll
    for (int kk = 0; kk < 16; ++kk) *(LAS f32x4g*)(scr + kk * 256 + lane * 4) = av[kk];
    LDS_WAIT(); asm volatile("" ::: "memory");
    const float* bp = w_pool + (size_t)g * 65536 + d0 + lane;
    float acc[16];
#pragma unroll
    for (int kk = 0; kk < 16; ++kk) acc[kk] = 0.f;
#pragma unroll 2
    for (int c = 0; c < 256; c += 4) {
        const float b0 = bp[(size_t)(c + 0) * 256], b1 = bp[(size_t)(c + 1) * 256], b2 = bp[(size_t)(c + 2) * 256], b3 = bp[(size_t)(c + 3) * 256];
#pragma unroll
        for (int kk = 0; kk < 16; ++kk) { const f32x4g a = *(const LAS f32x4g*)(scr + kk * 256 + c); acc[kk] += a.x * b0 + a.y * b1 + a.z * b2 + a.w * b3; }
    }
    u32x4g o0, o1;
    o0.x = pg8::cvt_pk_bf16(acc[0], acc[1]); o0.y = pg8::cvt_pk_bf16(acc[2], acc[3]); o0.z = pg8::cvt_pk_bf16(acc[4], acc[5]); o0.w = pg8::cvt_pk_bf16(acc[6], acc[7]);
    o1.x = pg8::cvt_pk_bf16(acc[8], acc[9]); o1.y = pg8::cvt_pk_bf16(acc[10], acc[11]); o1.z = pg8::cvt_pk_bf16(acc[12], acc[13]); o1.w = pg8::cvt_pk_bf16(acc[14], acc[15]);
    bf16r* orow = WT + (size_t)(1536 + g * 256 + d0 + lane) * 2048 + k0;
    *(u32x4g*)orow = o0; *(u32x4g*)(orow + 8) = o1;
    LDS_WAIT(); asm volatile("" ::: "memory");
}
#define XB_TMO      128
#define XB_XCNT(j)  (256  + 64 * (j))
#define XB_XSUB(j)  (1280 + 64 * (j))
#define XB_XGEN(j)  (2304 + 64 * (j))
#define XB_TOP      3328
#define XB_TOPGEN   3392
#define XCD_BAR_WORDS 3456
#define XB_SPIN_CAP (1u << 18)

__device__ __forceinline__ unsigned xb_ld(unsigned* p)              { return __hip_atomic_load(p, __ATOMIC_RELAXED, __HIP_MEMORY_SCOPE_AGENT); }
__device__ __forceinline__ unsigned xb_add(unsigned* p, unsigned v) { return __hip_atomic_fetch_add(p, v, __ATOMIC_RELAXED, __HIP_MEMORY_SCOPE_AGENT); }
__device__ __forceinline__ unsigned xb_xcc_id() { return (unsigned)__builtin_amdgcn_s_getreg((3 << 11) | 20) & 0xFu; }
#define XB_SPIN(cond, bar) do { unsigned _sp = 0; while (cond) { __builtin_amdgcn_s_sleep(1); \
    if ((++_sp & 255u) == 0u) { if (xb_ld(&(bar)[XB_TMO])) break; if (_sp > XB_SPIN_CAP) { atomicAdd(&(bar)[XB_TMO], 1u); break; } } } } while (0)

struct XcdBarrier {
    unsigned* bar; unsigned x;
    volatile __attribute__((address_space(3))) unsigned* st;
};

__device__ __forceinline__ XcdBarrier xcd_barrier_post(unsigned* bar, volatile __attribute__((address_space(3))) unsigned* st, bool leader) {
    XcdBarrier b; b.bar = bar; b.x = xb_xcc_id(); b.st = st;
    if (leader) (void)xb_add(&bar[XB_XCNT(b.x)], 1u);
    return b;
}
__device__ __forceinline__ void xcd_barrier_complete(unsigned* bar, unsigned x, unsigned& nloc, unsigned& nx) {
    const unsigned G = gridDim.x * gridDim.y * gridDim.z;
    unsigned sum, cnt, mine, sp = 0u;
    for (;;) {
        sum = 0u; cnt = 0u; mine = 0u;
#pragma unroll
        for (unsigned j = 0; j < 16; ++j) { const unsigned c = xb_ld(&bar[XB_XCNT(j)]); sum += c; cnt += (c > 0u) ? 1u : 0u; mine = (j == x) ? c : mine; }
        if (sum == G) break;
        __builtin_amdgcn_s_sleep(1);
        if ((++sp & 255u) == 0u) { if (xb_ld(&bar[XB_TMO])) break; if (sp > XB_SPIN_CAP) { atomicAdd(&bar[XB_TMO], 1u); break; } }
    }
    nloc = mine > 0u ? mine : 1u; nx = cnt > 0u ? cnt : 1u;
}

__device__ __attribute__((noinline)) void xcd_barrier(unsigned* bar_, unsigned x_, volatile __attribute__((address_space(3))) unsigned* st_, bool leader) {
    XcdBarrier b; b.bar = bar_; b.x = x_; b.st = st_;
    asm volatile("s_waitcnt vmcnt(0)" ::: "memory");
    __syncthreads();
    if (leader) {
        unsigned* bar = b.bar;
        __builtin_amdgcn_s_waitcnt(0);
        unsigned nloc = b.st[0], nx = b.st[1];
        if (nloc == 0u) { xcd_barrier_complete(bar, b.x, nloc, nx); b.st[0] = nloc; b.st[1] = nx; }
        const unsigned old = xb_add(&bar[XB_XSUB(b.x)], 1u);
        const unsigned gen = old / nloc;
        if (old + 1u == (gen + 1u) * nloc) {
            __builtin_amdgcn_fence(__ATOMIC_RELEASE, "agent");
            asm volatile("s_waitcnt vmcnt(0)" ::: "memory");
            const unsigned og = xb_add(&bar[XB_TOP], 1u);
            const unsigned tg = og / nx;
            if (og + 1u == (tg + 1u) * nx) xb_add(&bar[XB_TOPGEN], 1u);
            else XB_SPIN(xb_ld(&bar[XB_TOPGEN]) == tg, bar);
            __builtin_amdgcn_fence(__ATOMIC_ACQUIRE, "agent");
            xb_add(&bar[XB_XGEN(b.x)], 1u);
            asm volatile("s_waitcnt vmcnt(0)" ::: "memory");
        } else {
            XB_SPIN(xb_ld(&bar[XB_XGEN(b.x)]) == gen, bar);
            __builtin_amdgcn_fence(__ATOMIC_ACQUIRE, "agent");
            asm volatile("s_waitcnt vmcnt(0)" ::: "memory");
        }
    }
    __syncthreads();
}
__device__ __attribute__((noinline)) void grid_sync_fn() { cg::this_grid().sync(); }

struct Args { const float* in[14]; float* out; unsigned char* ws; int ph_lo, ph_hi; };
typedef const __attribute__((address_space(4))) Args* KArgs;
__device__ __forceinline__ KArgs kargs() { KArgs p = (KArgs)__builtin_amdgcn_kernarg_segment_ptr(); asm volatile("" : "+s"(p)); return p; }

__global__ void __launch_bounds__(512, 2) fwd_megakernel(Args args) {
    extern __shared__ __attribute__((aligned(16))) unsigned char lds[];
    const int wave = __builtin_amdgcn_readfirstlane((int)threadIdx.x >> 6);
    const int lane = (int)__builtin_amdgcn_mbcnt_hi(~0u, __builtin_amdgcn_mbcnt_lo(~0u, 0u)), tid = wave * 64 + lane;
    const int G = gridDim.x, bx = blockIdx.x;
#define KA_WS (kargs()->ws)
#define KA_IN(i) (kargs()->in[i])
#define KA_OUT (kargs()->out)
#define Win_t ((bf16r*)(KA_WS + WS_WIN))
#define Wpool_t ((bf16r*)(KA_WS + WS_WPOOL))
#define Wout_t ((bf16r*)(KA_WS + WS_WOUT))
#define Wup_t ((bf16r*)(KA_WS + WS_WUP))
#define Wdown_t ((bf16r*)(KA_WS + WS_WDOWN))
#define XN ((bf16r*)(KA_WS + WS_XN))
#define Z ((bf16r*)(KA_WS + WS_Z))
#define Dp ((bf16r*)(KA_WS + WS_D))
#define AM ((bf16r*)(KA_WS + WS_AM))
#define ACT ((bf16r*)(KA_WS + WS_ACT))
#define HS ((float*)(KA_WS + WS_HS))
#define HV ((float*)(KA_WS + WS_HV))
#define HG ((float*)(KA_WS + WS_HG))
#define SSQ ((float*)(KA_WS + WS_SS))
#define RSTD ((float*)(KA_WS + WS_RSTD))
    LAS unsigned char* ldsl = (LAS unsigned char*)lds;
    const int lo = kargs()->ph_lo, hi = kargs()->ph_hi;
#ifndef PHASE_MASK
#define PHASE_MASK 0x1ff
#endif
#define IN(k) (((PHASE_MASK >> (k)) & 1) && lo <= (k) && (k) < hi)
#ifndef PROBE_DUP
#define PROBE_DUP 0
#endif
#define NREP(k) (((PROBE_DUP >> (k)) & 1) ? 2 : 1)
#if MK_PER_PHASE
#define SEAM(k) do { } while (0)
#else
    volatile LAS unsigned* xbst = (volatile LAS unsigned*)(ldsl + XBST_OFF);
    if (tid == 0) { xbst[0] = 0u; xbst[1] = 0u; }
    unsigned xb_x = 0;
#define SEAM(k) do { if (IN(k) && IN((k) + 1)) { if ((k) == 0) { grid_sync_fn(); xb_x = xcd_barrier_post((unsigned*)(KA_WS + WS_BAR), xbst, tid == 0).x; } else { int ln_; asm volatile("v_mbcnt_lo_u32_b32 %0, -1, 0\n\tv_mbcnt_hi_u32_b32 %0, -1, %0" : "=v"(ln_)); xcd_barrier((unsigned*)(KA_WS + WS_BAR), xb_x, xbst, (wave == 0) && (ln_ == 0)); } } } while (0)
#endif
    const int gw = bx * 8 + wave, NGW = G * 8;
    const int gt = bx * 512 + tid, NGT = G * 512;

    if (IN(0)) {
        LAS float* scr = (LAS float*)(ldsl + wave * 16384);
        if (bx == 0) { unsigned* bw = (unsigned*)(KA_WS + WS_BAR); for (int i = tid; i < XCD_BAR_WORDS; i += 512) bw[i] = 0u; }
        constexpr int I_IN = 32 * 48  , I_FOLD = 4 * 32 * 16, I_OUT = 32 * 64;
        constexpr int NITEMS = I_IN + I_FOLD + I_OUT;
        const float* w_in = KA_IN(3); const float* w_out = KA_IN(8); const float* w_pool = KA_IN(6); unsigned char* wsb = KA_WS;
        for (int rp = 0; rp < NREP(0); ++rp) {
        for (int half = 0; half < 2; ++half) {
            const bool do_rows = (half == 0) == ((wave & 1) != 0);
            if (do_rows) { rms_rows_to_bf16(KA_IN(0), KA_IN(1), KA_IN(2), XN, gw, NGW, lane); continue; }
            for (int it = gw; it < NITEMS; it += NGW) {
                int r = it;
                if (r < I_FOLD) { fold_pool_item(w_in, w_pool, (bf16r*)(wsb + WS_WIN), scr, r, lane); continue; } r -= I_FOLD;
                if (r < I_IN) { const int kb = r / 48, nb = r % 48; transpose_item<0>(w_in, 2048, N_IN, (bf16r*)(wsb + WS_WIN), 0, scr, kb * 80 + nb, lane); continue; } r -= I_IN;
                transpose_item<0>(w_out, 2048, 2048, (bf16r*)(wsb + WS_WOUT), 0, scr, r, lane);
            }
        }
        }
    }
    SEAM(0);
#ifdef PROBE_SYNC
    for (int i_ = 0; i_ < PROBE_SYNC; ++i_) grid_sync_fn();
#endif
    if (IN(1)) {
        pg8::Gemm g{XN, Win_t, M_ALL, N_IN, 2048}; pg8::StaticOrder S; S.init(M_ALL, N_IN, G, bx); S.reps = NREP(1);
        pg8::EpiBf16 E{Z, N_IN, 0, 0, nullptr};
        pg8::gemm_phase<pg8::EpiBf16, pg8::StaticOrder, true, true>(ldsl, g, S, E, wave);
        {
            const int remu = (192 * 10) % G, nidle = remu ? G - remu : G, rank = remu ? bx - remu : bx;
            if (rank >= 0) {
                __syncthreads();
                LAS float* scr = (LAS float*)(ldsl + wave * 16384);
                constexpr int I_UP = 32 * 352, I_DOWN = 88 * 64;
                const float* w_up = KA_IN(10); const float* w_down = KA_IN(13); const float* g_ffn = KA_IN(9); unsigned char* wsb = KA_WS;
                for (int it = rank * 8 + wave; it < I_UP + I_DOWN; it += nidle * 8) {
                    if (it < I_UP) transpose_item<1>(w_up, 2048, N_UP, (bf16r*)(wsb + WS_WUP), 0, scr, it, lane, g_ffn);
                    else transpose_item<0>(w_down, D_FF, 2048, (bf16r*)(wsb + WS_WDOWN), 0, scr, it - I_UP, lane);
                }
            }
        }
    }
    SEAM(1);
    if (IN(2)) {
        bf16r* zb = Z; bf16r* amb = AM; const float* gk = KA_IN(5); const float* psc = KA_IN(7);
        const int sub = gt & 7, a = sub >> 2, ch = sub & 3;
        float invf[8];
#pragma unroll
        for (int i = 0; i < 8; ++i) invf[i] = __builtin_amdgcn_exp2f(-(float)(8 * ch + i) * 0.41524101186092029f) * 0.15915494309189535f;
        for (int item = gt >> 3; item < M_ALL * 2; item += NGT >> 3) {
            const int row = item >> 1, hh = 8 + (item & 1);
            const int t = row < M_P ? (row & (L_P - 1)) : ((row - M_P) & (L_S - 1));
            const float pos = (float)(a == 0 ? (t >> 6) : (t & 63));
            bf16r* p = zb + (size_t)row * N_IN + (hh < 8 ? hh * 128 : 1024 + (hh - 8) * 128) + 64 * a + 8 * ch;
            const float* gn = gk + 64 * a + 8 * ch;
            const u32x4g A = *(const u32x4g*)p, B = *(const u32x4g*)(p + 32);
            float x1[8] = {bf_lo(A.x), bf_hi(A.x), bf_lo(A.y), bf_hi(A.y), bf_lo(A.z), bf_hi(A.z), bf_lo(A.w), bf_hi(A.w)};
            float x2[8] = {bf_lo(B.x), bf_hi(B.x), bf_lo(B.y), bf_hi(B.y), bf_lo(B.z), bf_hi(B.z), bf_lo(B.w), bf_hi(B.w)};
            float ss = 0.f;
#pragma unroll
            for (int i = 0; i < 8; ++i) ss += x1[i] * x1[i] + x2[i] * x2[i];
            ss += __shfl_xor(ss, 1); ss += __shfl_xor(ss, 2); ss += __shfl_xor(ss, 4);
            const float rstd = 1.0f / sqrtf(ss * (1.f / 128.f) + RMS_EPS);
            const f32x4g g1a = *(const f32x4g*)gn, g1b = *(const f32x4g*)(gn + 4), g2a = *(const f32x4g*)(gn + 32), g2b = *(const f32x4g*)(gn + 36);
            const float g1[8] = {g1a.x, g1a.y, g1a.z, g1a.w, g1b.x, g1b.y, g1b.z, g1b.w}, g2[8] = {g2a.x, g2a.y, g2a.z, g2a.w, g2b.x, g2b.y, g2b.z, g2b.w};
            float o1[8], o2[8];
#pragma unroll
            for (int i = 0; i < 8; ++i) { const float y1 = x1[i] * rstd * g1[i], y2 = x2[i] * rstd * g2[i]; const float rev = pos * invf[i];
                const float cs = __builtin_amdgcn_cosf(rev), sn = __builtin_amdgcn_sinf(rev); o1[i] = y1 * cs - y2 * sn; o2[i] = y2 * cs + y1 * sn; }
            u32x4g OA, OB; OA.x = pg8::cvt_pk_bf16(o1[0], o1[1]); OA.y = pg8::cvt_pk_bf16(o1[2], o1[3]); OA.z = pg8::cvt_pk_bf16(o1[4], o1[5]); OA.w = pg8::cvt_pk_bf16(o1[6], o1[7]);
            OB.x = pg8::cvt_pk_bf16(o2[0], o2[1]); OB.y = pg8::cvt_pk_bf16(o2[2], o2[3]); OB.z = pg8::cvt_pk_bf16(o2[4], o2[5]); OB.w = pg8::cvt_pk_bf16(o2[6], o2[7]);
            *(u32x4g*)p = OA; *(u32x4g*)(p + 32) = OB;
        }
        for (int rp = 0; rp < NREP(2); ++rp)
        for (int item = gt; item < 4 * (M_ALL / 8) * 32; item += NGT) {
            const int g = item / ((M_ALL / 8) * 32), rem = item - g * ((M_ALL / 8) * 32), rb = rem >> 5, c8 = (rem & 31) * 8, row0 = rb * 8;
            const int L = row0 < M_P ? L_P : L_S, t0 = row0 < M_P ? (row0 & (L_P - 1)) : ((row0 - M_P) & (L_S - 1));
            const bf16r* vcol = zb + (size_t)(row0 - t0) * N_IN + 1536 + g * 256 + c8; bf16r* ocol = amb + (size_t)row0 * 2048 + 1024 + g * 256 + c8; const float* sc8 = psc + g * 256 + c8;
            if (g == 0) pool_item<1>(vcol, t0, L, sc8, ocol); else if (g == 1) pool_item<2>(vcol, t0, L, sc8, ocol); else if (g == 2) pool_item<4>(vcol, t0, L, sc8, ocol); else pool_item<8>(vcol, t0, L, sc8, ocol);
        }
    }
    SEAM(2);
    if (IN(3)) {
        for (int Lu_ = bx; Lu_ < 1536 * NREP(3); Lu_ += G) { const int Lu = Lu_ % 1536;
            const int r = Lu >> 8, cc = Lu & 255, x = cc & 7, slot = cc >> 3, b = x >> 1, kvh = x & 1;
            int head, qb, seq, row0;
            if (r < 4) { head = kvh * 4 + r; qb = slot; seq = L_S; row0 = M_P + b * L_S; }
            else { head = kvh * 4 + (r - 4) * 2 + (slot >> 4); qb = slot & 15; seq = L_P; row0 = b * L_P; }
            const bf16r* zb = Z;
            const att::bf16* Qb = (const att::bf16*)(zb + (size_t)(row0 + qb * 256) * N_IN + head * 128);
            const att::bf16* Kh = (const att::bf16*)(zb + (size_t)row0 * N_IN + 1024 + kvh * 128);
            const att::bf16* Vh = (const att::bf16*)(zb + (size_t)row0 * N_IN + 1280 + kvh * 128);
            unsigned* Ob = (unsigned*)(AM + (size_t)(row0 + qb * 256) * 2048 + head * 128);
            att::attn_dense_body<att::bf16>(Qb, Kh, Vh, Ob, seq, (char*)lds, KA_IN(4), qb * 256, KA_IN(5), wave);
        }
    }
    SEAM(3);
    if (IN(4)) {
        pg8::Gemm g{AM, Wout_t, M_ALL, 2048, 2048}; pg8::StaticOrder S; S.init(M_ALL, 2048, G, bx); S.reps = NREP(4);
        pg8::EpiResNorm E{KA_IN(0), KA_IN(1), XN, SSQ, (LAS float*)(ldsl + XCH_OFF)};
        pg8::gemm_phase<pg8::EpiResNorm, pg8::StaticOrder, true, true>(ldsl, g, S, E, wave);
    }
#ifdef PROBE_X4
    if (IN(4)) { __syncthreads();
        pg8::Gemm g{AM, Wout_t, M_ALL, 2048, 2048}; pg8::StaticOrder S; S.init(M_ALL, 2048, G, bx);
        pg8::EpiBf16 E{ACT, 2048, 0, 0, nullptr};
        pg8::gemm_phase<pg8::EpiBf16, pg8::StaticOrder, true, true>(ldsl, g, S, E, wave);
    }
#endif
    SEAM(4);
    if (IN(5)) {
        const float* ssq = SSQ; float* rstd = RSTD;
        for (int row = gt; row < M_ALL; row += NGT) { float q = 0.f;
#pragma unroll
            for (int p = 0; p < 8; ++p) q += ssq[(size_t)p * M_ALL + row];
            rstd[row] = 1.0f / sqrtf(q * (1.f / 2048.f) + RMS_EPS); }
    }
    SEAM(5);
    if (IN(6)) {
        pg8::Gemm g{XN, Wup_t, M_ALL, N_UP, 2048}; pg8::StaticOrder S; S.init(M_ALL, N_UP, G, bx); S.reps = NREP(6);
        pg8::EpiConvGlu E{ACT, KA_IN(11), KA_IN(12), HS, HV, HG, (LAS float*)(ldsl + XCH_OFF), RSTD};
        pg8::gemm_phase<pg8::EpiConvGlu, pg8::StaticOrder, true, true>(ldsl, g, S, E, wave);
    }
    SEAM(6);
    if (IN(7)) {
        const float* wc = KA_IN(11); const float* hs = HS; const float* hv = HV; const float* hg = HG; bf16r* actb = ACT;
        for (int item = gt; item < N_TILES_M * 2 * (D_FF / 4); item += NGT) {
            const int c4 = (item % (D_FF / 4)) * 4, pe = item / (D_FF / 4), pm = pe >> 1, e = pe & 1;
            const int tps = pm < 64 ? 16 : 32, ti = pm < 64 ? (pm & 15) : ((pm - 64) & 31);
            if (e == 0 ? (ti == 0) : (ti == tps - 1)) continue;
            const size_t ho = (size_t)pe * D_FF + c4;
            const f32x4g s0 = *(const f32x4g*)(hs + ho), v = *(const f32x4g*)(hv + ho);
            const f32x4g gn = e == 0 ? *(const f32x4g*)(hg + ((size_t)(pm - 1) * 2 + 1) * D_FF + c4) : *(const f32x4g*)(hg + ((size_t)(pm + 1) * 2 + 0) * D_FF + c4);
            const f32x4g w = *(const f32x4g*)(wc + (e == 0 ? 0 : 2 * D_FF) + c4);
            const f32x4g s = s0 + w * gn;
            u32x2g o; o.x = pg8::cvt_pk_bf16(pg8::silu_f(s.x) * v.x, pg8::silu_f(s.y) * v.y); o.y = pg8::cvt_pk_bf16(pg8::silu_f(s.z) * v.z, pg8::silu_f(s.w) * v.w);
            *(u32x2g*)(actb + ((size_t)pm * 256 + (e ? 255 : 0)) * D_FF + c4) = o;
        }
    }
    SEAM(7);
    if (IN(8)) {
        pg8::Gemm g{ACT, Wdown_t, M_ALL, 2048, D_FF}; pg8::StaticOrder S; S.init(M_ALL, 2048, G, bx); S.reps = NREP(8);
        pg8::EpiResOut E{XN, KA_OUT};
        pg8::gemm_phase<pg8::EpiResOut, pg8::StaticOrder, true, true>(ldsl, g, S, E, wave);
    }
#undef IN
#undef SEAM
}

extern "C" void kernel_launch(void* const* d_in, const int* in_sizes, int n_in, void* d_out, int out_size, void* d_ws, size_t ws_size, hipStream_t stream) {
    static int grid = 0;
    if (grid == 0) {
        if (n_in != 14 || in_sizes[0] != M_P * 2048 || in_sizes[1] != M_S * 2048 || out_size != M_ALL * 2048 || ws_size < WS_END) {
            fprintf(stderr, "kernel_launch: shape mismatch (n_in %d, in0 %d, in1 %d, out %d, ws %zu; need ws >= %zu)\n", n_in, n_in > 0 ? in_sizes[0] : -1, n_in > 1 ? in_sizes[1] : -1, out_size, ws_size, (size_t)WS_END);
            grid = -1; return; }
        int dev = 0, cus = 0, per_cu = 0;
        if (hipGetDevice(&dev) != hipSuccess || hipDeviceGetAttribute(&cus, hipDeviceAttributeMultiprocessorCount, dev) != hipSuccess) { grid = -1; return; }
        if (hipFuncSetAttribute((const void*)fwd_megakernel, hipFuncAttributeMaxDynamicSharedMemorySize, LDS_BYTES) != hipSuccess) { fprintf(stderr, "kernel_launch: hipFuncSetAttribute failed\n"); grid = -1; return; }
        if (hipOccupancyMaxActiveBlocksPerMultiprocessor(&per_cu, (const void*)fwd_megakernel, 512, LDS_BYTES) != hipSuccess || per_cu < 1) { fprintf(stderr, "kernel_launch: occupancy query gave %d\n", per_cu); per_cu = 1; }
        (void)hipGetLastError();
        grid = cus * 1;
        if (grid <= 0) { grid = -1; return; }
    }
    if (grid < 0) return;
    Args a{};
    for (int i = 0; i < 14; ++i) a.in[i] = (const float*)d_in[i];
    a.out = (float*)d_out; a.ws = (unsigned char*)d_ws;
#if MK_PER_PHASE
    for (int ph = 0; ph < N_PHASES; ++ph) { a.ph_lo = ph; a.ph_hi = ph + 1; hipLaunchKernelGGL(fwd_megakernel, dim3(grid), dim3(512), LDS_BYTES, stream, a); }
#else
    a.ph_lo = 0; a.ph_hi = N_PHASES;
    void* kargs[] = {&a};
    const hipError_t e = hipLaunchCooperativeKernel((const void*)fwd_megakernel, dim3(grid), dim3(512), kargs, LDS_BYTES, stream);
    if (e != hipSuccess) fprintf(stderr, "kernel_launch: cooperative launch failed: %s (grid %d)\n", hipGetErrorString(e), grid);
#endif
}
```
